# Optimizing an MI355X kernel written in HIP

```python
import math
import jax, jax.numpy as jnp
from jax import lax
import numpy as np

D_MODEL = 1024
BATCH = 8
SEQ = 4096
DEPTH = 4

N_META = 16
CHUNK = 64
META_PAD = CHUNK - N_META
CONV_K = 4
D_FF = 2816
LRU_WIDTH = D_MODEL // 4
LRU_HEADS = 4
LRU_BLOCK = LRU_WIDTH // LRU_HEADS
LRU_C = 8.0
SSD_HEADS = 8
SSD_HEADDIM = 64
SSD_INNER = SSD_HEADS * SSD_HEADDIM
SSD_GROUPS = 2
SSD_HPG = SSD_HEADS // SSD_GROUPS
SSD_STATE = 64
SSD_CONV_DIM = SSD_INNER + 2 * SSD_GROUPS * SSD_STATE
DN_HEADS = 4
DN_DK = 64
DN_DV = 64
DN_CONV_DIM = DN_HEADS * (2 * DN_DK + DN_DV)
MIX_WIDTH = LRU_WIDTH + SSD_INNER + DN_HEADS * DN_DV
IN_SIZES = (LRU_WIDTH, LRU_WIDTH,
            SSD_INNER, SSD_CONV_DIM, SSD_HEADS,
            DN_CONV_DIM, DN_HEADS * DN_DV, DN_HEADS, DN_HEADS)
D_IN = sum(IN_SIZES)
IN_OFFSETS = [int(s) for s in np.cumsum(IN_SIZES)[:-1]]
DEEPNORM_ALPHA = (2 * DEPTH) ** 0.25
DEEPNORM_BETA = (8 * DEPTH) ** -0.25
FFN_RES = 0.5
LN_EPS = 1e-5
RMS_EPS = 1e-6

kernel_name = 'hymba_deepnorm_lru_ssd_deltanet_macaron'

F32 = jnp.float32


def _layer_norm(x, g, b):
    xf = x.astype(F32)
    mu = jnp.mean(xf, axis=-1, keepdims=True)
    var = jnp.mean(jnp.square(xf - mu), axis=-1, keepdims=True)
    return ((xf - mu) * lax.rsqrt(var + LN_EPS) * g.astype(F32) + b.astype(F32)).astype(x.dtype)


def _rms_norm(x, w):
    xf = x.astype(F32)
    return xf * lax.rsqrt(jnp.mean(xf * xf, axis=-1, keepdims=True) + RMS_EPS) * w.astype(F32)


def _l2norm(x):
    return x * lax.rsqrt(jnp.sum(x * x, axis=-1, keepdims=True) + RMS_EPS)


def _causal_conv(x, w, b=None):
    c = x.shape[-1]
    y = lax.conv_general_dilated(x, w[:, None, :].astype(x.dtype), window_strides=(1,),
                                 padding=[(CONV_K - 1, 0)], dimension_numbers=('NWC', 'WIO', 'NWC'),
                                 feature_group_count=c)
    if b is not None:
        y = y + b.astype(x.dtype)
    return y


def _pad_front(x):
    pad = [(0, 0)] * x.ndim
    pad[1] = (META_PAD, 0)
    return jnp.pad(x, pad)


def _swiglu(x, wg, wu, wd):
    return (jax.nn.silu(x @ wg) * (x @ wu)) @ wd


def _segsum(x):
    cs = jnp.cumsum(x, axis=-1)
    n = x.shape[-1]
    mask = jnp.tril(jnp.ones((n, n), dtype=bool))
    return jnp.where(mask, cs[..., :, None] - cs[..., None, :], -jnp.inf)


def _linear_combine(c1, c2):
    a1, b1 = c1
    a2, b2 = c2
    return a1 * a2, a2 * b1 + b2


def _rg_lru_group(u_raw, y_raw, conv_w, conv_b, w_a, b_a, w_x, b_x, lam):
    u = _causal_conv(u_raw, conv_w, conv_b).astype(F32)
    bsz, t, _ = u.shape
    uh = u.reshape(bsz, t, LRU_HEADS, LRU_BLOCK)
    r = jax.nn.sigmoid(jnp.einsum('bthi,hij->bthj', uh, w_a.astype(F32)).reshape(bsz, t, LRU_WIDTH) + b_a.astype(F32))
    i = jax.nn.sigmoid(jnp.einsum('bthi,hij->bthj', uh, w_x.astype(F32)).reshape(bsz, t, LRU_WIDTH) + b_x.astype(F32))
    log_a = -LRU_C * r * jax.nn.softplus(-lam.astype(F32))
    a = jnp.exp(log_a)
    b = jnp.sqrt(-jnp.expm1(2.0 * log_a)) * (i * u)
    _, h = lax.associative_scan(_linear_combine, (a, b), axis=1)
    return (h * jax.nn.gelu(y_raw.astype(F32))).astype(u_raw.dtype)


def _ssd_chunked(x, a, b, c):
    bsz, L, ng, ne, p = x.shape
    nc = L // CHUNK
    x = x.reshape(bsz, nc, CHUNK, ng, ne, p)
    b = b.reshape(bsz, nc, CHUNK, ng, -1)
    c = c.reshape(bsz, nc, CHUNK, ng, -1)
    a = jnp.transpose(a.reshape(bsz, nc, CHUNK, ng, ne), (0, 3, 4, 1, 2))
    a_cs = jnp.cumsum(a, axis=-1)
    l_mat = jnp.exp(_segsum(a))
    y_diag = jnp.einsum('bclgn,bcsgn,bgecls,bcsgep->bclgep', c, b, l_mat, x)
    decay_states = jnp.exp(a_cs[..., -1:] - a_cs)
    states = jnp.einsum('bclgn,bgecl,bclgep->bcgepn', b, decay_states, x)
    states = jnp.concatenate([jnp.zeros_like(states[:, :1]), states], axis=1)
    chunk_tot = jnp.pad(a_cs[..., -1], ((0, 0), (0, 0), (0, 0), (1, 0)))
    decay_chunk = jnp.exp(_segsum(chunk_tot))
    states = jnp.einsum('bgezc,bcgepn->bzgepn', decay_chunk, states)[:, :-1]
    y_off = jnp.einsum('bclgn,bcgepn,bgecl->bclgep', c, states, jnp.exp(a_cs))
    return (y_diag + y_off).reshape(bsz, L, ng, ne, p)


def _ssd_group(z, xbc_raw, dt_raw, conv_w, conv_b, dt_bias, a_log, d_skip, norm_w):
    xbc = jax.nn.silu(_causal_conv(xbc_raw, conv_w, conv_b)).astype(F32)
    bsz, t, _ = xbc.shape
    xs = xbc[..., :SSD_INNER].reshape(bsz, t, SSD_GROUPS, SSD_HPG, SSD_HEADDIM)
    bm = xbc[..., SSD_INNER:SSD_INNER + SSD_GROUPS * SSD_STATE].reshape(bsz, t, SSD_GROUPS, SSD_STATE)
    cm = xbc[..., SSD_INNER + SSD_GROUPS * SSD_STATE:].reshape(bsz, t, SSD_GROUPS, SSD_STATE)
    dt = jax.nn.softplus(dt_raw.astype(F32) + dt_bias.astype(F32)).reshape(bsz, t, SSD_GROUPS, SSD_HPG)
    a = -jnp.exp(a_log.astype(F32)).reshape(SSD_GROUPS, SSD_HPG)
    y = _ssd_chunked(_pad_front(xs * dt[..., None]), _pad_front(dt * a), _pad_front(bm), _pad_front(cm))[:, META_PAD:]
    y = y + d_skip.astype(F32).reshape(SSD_GROUPS, SSD_HPG)[:, :, None] * xs
    gw = SSD_HPG * SSD_HEADDIM
    y = y.reshape(bsz, t, SSD_GROUPS, gw) * jax.nn.silu(z.astype(F32)).reshape(bsz, t, SSD_GROUPS, gw)
    y = _rms_norm(y, norm_w.reshape(SSD_GROUPS, gw))
    return y.reshape(bsz, t, SSD_INNER).astype(z.dtype)


def _gated_delta_chunked(q, k, v, beta, g):
    bsz, nh, L, dk = q.shape
    dv = v.shape[-1]
    nc = L // CHUNK
    q = q.reshape(bsz, nh, nc, CHUNK, dk)
    k = k.reshape(bsz, nh, nc, CHUNK, dk)
    v = v.reshape(bsz, nh, nc, CHUNK, dv)
    beta = beta.reshape(bsz, nh, nc, CHUNK)
    g_cs = jnp.cumsum(g.reshape(bsz, nh, nc, CHUNK), axis=-1)
    incl = jnp.tril(jnp.ones((CHUNK, CHUNK), dtype=bool))
    strict = jnp.tril(jnp.ones((CHUNK, CHUNK), dtype=bool), k=-1)
    decay = jnp.exp(jnp.where(incl, g_cs[..., :, None] - g_cs[..., None, :], -jnp.inf))
    k_beta = k * beta[..., None]
    v_beta = v * beta[..., None]
    m = jnp.where(strict, jnp.einsum('bhnid,bhnjd->bhnij', k_beta, k) * decay, 0.0)
    eye = jnp.eye(CHUNK, dtype=m.dtype)
    rhs = jnp.concatenate([v_beta, k_beta * jnp.exp(g_cs)[..., None]], axis=-1)
    sol = lax.linalg.triangular_solve(eye + m, rhs, left_side=True, lower=True, unit_diagonal=True)
    u, w = sol[..., :dv], sol[..., dv:]
    attn = jnp.where(incl, jnp.einsum('bhnid,bhnjd->bhnij', q, k) * decay, 0.0)
    q_dec = q * jnp.exp(g_cs)[..., None]
    k_dec = k * jnp.exp(g_cs[..., -1:] - g_cs)[..., None]
    chunk_decay = jnp.exp(g_cs[..., -1])

    def step(state, inp):
        qd, kd, uu, ww, aa, cd = inp
        v_new = uu - jnp.einsum('bhcd,bhdv->bhcv', ww, state)
        out = jnp.einsum('bhcd,bhdv->bhcv', qd, state) + jnp.einsum('bhij,bhjv->bhiv', aa, v_new)
        state = state * cd[..., None, None] + jnp.einsum('bhcd,bhcv->bhdv', kd, v_new)
        return state, out

    xs = tuple(jnp.moveaxis(z, 2, 0) for z in (q_dec, k_dec, u, w, attn, chunk_decay))
    s0 = jnp.zeros((bsz, nh, dk, dv), q.dtype)
    _, o = lax.scan(step, s0, xs)
    return jnp.moveaxis(o, 0, 2).reshape(bsz, nh, L, dv)


def _deltanet_group(qkv_raw, gate_raw, beta_raw, alpha_raw, conv_w, a_log, dt_bias, norm_w):
    qkv = jax.nn.silu(_causal_conv(qkv_raw, conv_w)).astype(F32)
    bsz, t, _ = qkv.shape
    nq = DN_HEADS * DN_DK
    q = _l2norm(qkv[..., :nq].reshape(bsz, t, DN_HEADS, DN_DK)) * (DN_DK ** -0.5)
    k = _l2norm(qkv[..., nq:2 * nq].reshape(bsz, t, DN_HEADS, DN_DK))
    v = qkv[..., 2 * nq:].reshape(bsz, t, DN_HEADS, DN_DV)
    beta = jax.nn.sigmoid(beta_raw.astype(F32))
    g = -jnp.exp(a_log.astype(F32)) * jax.nn.softplus(alpha_raw.astype(F32) + dt_bias.astype(F32))
    to_h = lambda z: jnp.swapaxes(_pad_front(z), 1, 2)
    o = _gated_delta_chunked(to_h(q), to_h(k), to_h(v), to_h(beta), to_h(g))
    o = jnp.swapaxes(o, 1, 2)[:, META_PAD:]
    o = _rms_norm(o, norm_w) * jax.nn.silu(gate_raw.astype(F32).reshape(bsz, t, DN_HEADS, DN_DV))
    return o.reshape(bsz, t, DN_HEADS * DN_DV).astype(qkv_raw.dtype)


def setup_inputs(seed: int = 0) -> dict:
    key = jax.random.key(seed)
    ks = jax.random.split(key, 26)
    nrm = lambda k, shape, s: jax.random.normal(k, shape, F32) * s
    unif = lambda k, shape, lo, hi: jax.random.uniform(k, shape, F32, lo, hi)

    def dt_bias_init(k, n):
        dt = jnp.exp(unif(k, (DEPTH, n), math.log(1e-3), math.log(1e-1)))
        return dt + jnp.log(-jnp.expm1(-dt))

    a_c = unif(ks[14], (DEPTH, LRU_WIDTH), 0.9, 0.999)
    s = a_c ** (1.0 / LRU_C)
    return {
        'x': nrm(ks[0], (BATCH, SEQ, D_MODEL), 1.0),
        'meta': nrm(ks[1], (N_META, D_MODEL), 1.0),
        'ln_g': 1.0 + nrm(ks[2], (DEPTH, 3, D_MODEL), 0.02),
        'ln_b': nrm(ks[3], (DEPTH, 3, D_MODEL), 0.02),
        'ffn_w_gate': nrm(ks[4], (DEPTH, 2, D_MODEL, D_FF), D_MODEL ** -0.5),
        'ffn_w_up': nrm(ks[5], (DEPTH, 2, D_MODEL, D_FF), D_MODEL ** -0.5),
        'ffn_w_down': nrm(ks[6], (DEPTH, 2, D_FF, D_MODEL), D_FF ** -0.5 * DEEPNORM_BETA),
        'w_in': nrm(ks[7], (DEPTH, D_MODEL, D_IN), D_MODEL ** -0.5),
        'lru_conv_w': nrm(ks[8], (DEPTH, CONV_K, LRU_WIDTH), CONV_K ** -0.5),
        'lru_conv_b': nrm(ks[9], (DEPTH, LRU_WIDTH), 0.01),
        'lru_w_a': nrm(ks[10], (DEPTH, LRU_HEADS, LRU_BLOCK, LRU_BLOCK), LRU_BLOCK ** -0.5),
        'lru_b_a': nrm(ks[11], (DEPTH, LRU_WIDTH), 0.01),
        'lru_w_x': nrm(ks[12], (DEPTH, LRU_HEADS, LRU_BLOCK, LRU_BLOCK), LRU_BLOCK ** -0.5),
        'lru_b_x': nrm(ks[13], (DEPTH, LRU_WIDTH), 0.01),
        'lru_lambda': jnp.log(s) - jnp.log1p(-s),
        'ssd_conv_w': nrm(ks[15], (DEPTH, CONV_K, SSD_CONV_DIM), CONV_K ** -0.5),
        'ssd_conv_b': nrm(ks[16], (DEPTH, SSD_CONV_DIM), 0.01),
        'ssd_dt_bias': dt_bias_init(ks[17], SSD_HEADS),
        'ssd_a_log': jnp.log(unif(ks[18], (DEPTH, SSD_HEADS), 1.0, 16.0)),
        'ssd_d': 1.0 + nrm(ks[19], (DEPTH, SSD_HEADS), 0.01),
        'ssd_norm_w': 1.0 + nrm(ks[20], (DEPTH, SSD_INNER), 0.01),
        'dn_conv_w': nrm(ks[21], (DEPTH, CONV_K, DN_CONV_DIM), CONV_K ** -0.5),
        'dn_a_log': jnp.log(unif(ks[22], (DEPTH, DN_HEADS), 1.0, 16.0)),
        'dn_dt_bias': dt_bias_init(ks[23], DN_HEADS),
        'dn_norm_w': 1.0 + nrm(ks[24], (DEPTH, DN_DV), 0.01),
        'w_out': nrm(ks[25], (DEPTH, MIX_WIDTH, D_MODEL), MIX_WIDTH ** -0.5 * DEEPNORM_BETA),
    }


def reference(x, meta, ln_g, ln_b, ffn_w_gate, ffn_w_up, ffn_w_down, w_in,
              lru_conv_w, lru_conv_b, lru_w_a, lru_b_a, lru_w_x, lru_b_x, lru_lambda,
              ssd_conv_w, ssd_conv_b, ssd_dt_bias, ssd_a_log, ssd_d, ssd_norm_w,
              dn_conv_w, dn_a_log, dn_dt_bias, dn_norm_w, w_out):
    bsz = x.shape[0]
    h = jnp.concatenate([jnp.broadcast_to(meta.astype(x.dtype)[None], (bsz, N_META, D_MODEL)), x], axis=1)
    for l in range(DEPTH):
        h = _layer_norm(DEEPNORM_ALPHA * h + FFN_RES * _swiglu(h, ffn_w_gate[l, 0], ffn_w_up[l, 0], ffn_w_down[l, 0]),
                        ln_g[l, 0], ln_b[l, 0])
        (lru_u, lru_y, ssd_z, ssd_xbc, ssd_dt, dn_qkv, dn_gate, dn_beta, dn_alpha) = jnp.split(h @ w_in[l], IN_OFFSETS, axis=-1)
        o_lru = _rg_lru_group(lru_u, lru_y, lru_conv_w[l], lru_conv_b[l], lru_w_a[l], lru_b_a[l],
                              lru_w_x[l], lru_b_x[l], lru_lambda[l])
        o_ssd = _ssd_group(ssd_z, ssd_xbc, ssd_dt, ssd_conv_w[l], ssd_conv_b[l], ssd_dt_bias[l],
                           ssd_a_log[l], ssd_d[l], ssd_norm_w[l])
        o_dn = _deltanet_group(dn_qkv, dn_gate, dn_beta, dn_alpha, dn_conv_w[l], dn_a_log[l],
                               dn_dt_bias[l], dn_norm_w[l])
        mix = jnp.concatenate([o_lru, o_ssd, o_dn], axis=-1) @ w_out[l]
        h = _layer_norm(DEEPNORM_ALPHA * h + mix, ln_g[l, 1], ln_b[l, 1])
        h = _layer_norm(DEEPNORM_ALPHA * h + FFN_RES * _swiglu(h, ffn_w_gate[l, 1], ffn_w_up[l, 1], ffn_w_down[l, 1]),
                        ln_g[l, 2], ln_b[l, 2])
    return h[:, N_META:]
```

```cpp
#include <hip/hip_runtime.h>
namespace pg8 {
#define PG8_LAS __attribute__((address_space(3)))
typedef unsigned short bf16_t;
typedef short bf16x8 __attribute__((ext_vector_type(8)));
typedef float f32x4 __attribute__((ext_vector_type(4)));
typedef unsigned u32x4 __attribute__((ext_vector_type(4)));
constexpr int BM = 256, BK = 64, HALF = 128, HTB = HALF * BK * 2  , STAGE_BYTES = 8 * HTB, NXCD = 8, WGM = 8;

__host__ __device__ __forceinline__ int lds_byte(int r, int c) { const int st = (r >> 4) * 2 + (c >> 5), rr = r & 15, cc = c & 31, ob = rr * 64 + cc * 2; return st * 1024 + (ob ^ (((ob >> 9) & 1) << 5)); }
__host__ __device__ __forceinline__ void stage_rc(int b, int& R, int& C) { const int st = b / 1024, sb = b % 1024, swz = sb ^ (((sb >> 9) & 1) << 5); R = (st >> 1) * 16 + swz / 64; C = (st & 1) * 32 + (swz % 64) / 2; }
__host__ __device__ __forceinline__ int perm32(int rho) { const int n = rho >> 4, i = rho & 15; return 8 * (i >> 2) + 4 * n + (i & 3); }

struct Unit { int pm, pn; };
struct Gemm { const bf16_t* A; const bf16_t* Bt; int M, N, K; };

struct StaticOrder {
    int nM, nN, nwg, G, c;
    __host__ __device__ void init(int M, int N, int G_, int c_) { nM = M / BM; nN = N / BM; nwg = nM * nN; G = G_; c = c_; }
    __host__ __device__ bool next(int i, Unit& u) const {
        const long L = (long)i * G + c; if (L >= nwg) return false;
        int wgid = (int)L; { const int q = nwg / NXCD, r = nwg % NXCD, xcd = wgid % NXCD, off = wgid / NXCD; wgid = (xcd < r ? xcd * (q + 1) : r * (q + 1) + (xcd - r) * q) + off; }
        const int nig = WGM * nN, gid = wgid / nig, fm = gid * WGM, gsz = (nM - fm) < WGM ? (nM - fm) : WGM;
        u.pm = fm + ((wgid % nig) % gsz); u.pn = (wgid % nig) / gsz; return true;
    }
    __device__ __forceinline__ void a_ready(const Unit&) const {}
    __device__ __forceinline__ void done(const Unit&) const {}
};
struct CountedOrder : StaticOrder {
    const unsigned* ready; unsigned need; unsigned* tmo;
    __device__ __forceinline__ void a_ready(const Unit& u) const {
        if (threadIdx.x < 64) {
            const unsigned long long t0 = __builtin_amdgcn_s_memrealtime(); unsigned polls = 0;
            while ((unsigned)__builtin_amdgcn_readfirstlane(__hip_atomic_load(ready + 64 * u.pm, __ATOMIC_RELAXED, __HIP_MEMORY_SCOPE_AGENT)) < need) {
                if ((++polls & 255u) == 0u && __builtin_amdgcn_readfirstlane(__hip_atomic_load(tmo, __ATOMIC_RELAXED, __HIP_MEMORY_SCOPE_AGENT)) != 0u) break;
                if (__builtin_amdgcn_s_memrealtime() - t0 > 2000000ull) {
                    if (threadIdx.x == 0) { unsigned expect = 0u; __hip_atomic_compare_exchange_strong(tmo + 1, &expect, 0x600u | (unsigned)(u.pm & 0xff), __ATOMIC_RELAXED, __ATOMIC_RELAXED, __HIP_MEMORY_SCOPE_AGENT); __hip_atomic_store(tmo, 1u, __ATOMIC_RELAXED, __HIP_MEMORY_SCOPE_AGENT); }
                    break; }
                __builtin_amdgcn_s_sleep(2); }
            __builtin_amdgcn_fence(__ATOMIC_ACQUIRE, "agent");
            asm volatile("s_waitcnt vmcnt(0)" ::: "memory");
        }
#if !defined(BROKEN_HOOK_NO_BARRIER)
        asm volatile("" ::: "memory"); __builtin_amdgcn_s_barrier(); asm volatile("" ::: "memory");
#endif
    }
};

__device__ __forceinline__ unsigned cvt_pk_bf16(float lo, float hi) { unsigned r; asm volatile("v_cvt_pk_bf16_f32 %0, %1, %2" : "=v"(r) : "v"(lo), "v"(hi)); return r; }
typedef float f32x2 __attribute__((ext_vector_type(2)));
__device__ __forceinline__ f32x2 gelu_pk(f32x2 v) {
    const f32x2 av = __builtin_elementwise_abs(v), d = av * 0.2316418882f + 1.0f;
    f32x2 t; t.x = __builtin_amdgcn_rcpf(d.x); t.y = __builtin_amdgcn_rcpf(d.y);
    f32x2 q = t * 0.5307027145f + (-0.7265760135f); q = q * t + 0.7107068705f; q = q * t + (-0.142248368f); q = q * t + 0.127414796f; q = q * t;
    const f32x2 s = (v * v) * (-0.72134752044f);
    f32x2 e; e.x = __builtin_amdgcn_exp2f(s.x); e.y = __builtin_amdgcn_exp2f(s.y);
    const f32x2 m = v * (q * e), r = v - m;
    f32x2 o; o.x = v.x < 0.f ? m.x : r.x; o.y = v.y < 0.f ? m.y : r.y; return o;
}

struct EpiF32 {
    static constexpr bool PERM = false, AFTER_DRAIN = false;
    float* C; int ldc; const float* bias;
    __device__ __forceinline__ void operator()(const f32x4 (&acc)[2][2][4][2], const Unit& u, int wr, int wc, int fr, int fq) const {
        const int row0 = u.pm * BM + wr * 64 + fr, col0 = u.pn * BM + wc * 32 + 4 * fq;
        f32x4 bv[2][2];
#pragma unroll
        for (int bj = 0; bj < 2; ++bj)
#pragma unroll
            for (int n = 0; n < 2; ++n) bv[bj][n] = bias ? *(const f32x4*)(bias + col0 + bj * HALF + n * 16) : (f32x4){0.f, 0.f, 0.f, 0.f};
#pragma unroll
        for (int ai = 0; ai < 2; ++ai)
#pragma unroll
            for (int m = 0; m < 4; ++m) { float* rowp = C + (size_t)(row0 + ai * HALF + m * 16) * ldc + col0;
#pragma unroll
                for (int bj = 0; bj < 2; ++bj)
#pragma unroll
                    for (int n = 0; n < 2; ++n) *(f32x4*)(rowp + bj * HALF + n * 16) = acc[ai][bj][m][n] + bv[bj][n]; }
    }
};
template <int ACT  > struct EpiBf16 {
    static constexpr bool PERM = true, AFTER_DRAIN = false;
    bf16_t* O; int ldc; const float* bias; int split_cols; size_t split_stride;
    __device__ __forceinline__ void operator()(const f32x4 (&acc)[2][2][4][2], const Unit& u, int wr, int wc, int fr, int fq) const {
        const int row0 = u.pm * BM + wr * 64 + fr; int colt = u.pn * BM; bf16_t* base = O;
        if (split_cols) { const int t = colt / split_cols; base += (size_t)t * split_stride; colt -= t * split_cols; }
        const int col0 = colt + wc * 32 + 8 * fq, bcol0 = u.pn * BM + wc * 32 + 8 * fq;
        f32x4 bv[2][2];
#pragma unroll
        for (int bj = 0; bj < 2; ++bj)
#pragma unroll
            for (int n = 0; n < 2; ++n) bv[bj][n] = bias ? *(const f32x4*)(bias + bcol0 + bj * HALF + 4 * n) : (f32x4){0.f, 0.f, 0.f, 0.f};
#pragma unroll
        for (int ai = 0; ai < 2; ++ai)
#pragma unroll
            for (int m = 0; m < 4; ++m) { bf16_t* rowp = base + (size_t)(row0 + ai * HALF + m * 16) * ldc + col0;
#pragma unroll
                for (int bj = 0; bj < 2; ++bj) { f32x4 v0 = acc[ai][bj][m][0] + bv[bj][0], v1 = acc[ai][bj][m][1] + bv[bj][1];
                    if (ACT == 1) { f32x2 a = gelu_pk((f32x2){v0[0], v0[1]}), b = gelu_pk((f32x2){v0[2], v0[3]}), c = gelu_pk((f32x2){v1[0], v1[1]}), d = gelu_pk((f32x2){v1[2], v1[3]});
                        v0 = (f32x4){a.x, a.y, b.x, b.y}; v1 = (f32x4){c.x, c.y, d.x, d.y}; }
                    if (ACT == 2) {
#pragma unroll
                        for (int j = 0; j < 4; ++j) { v0[j] = 0.5f * v0[j] * (1.0f + erff(v0[j] * 0.70710678f)); v1[j] = 0.5f * v1[j] * (1.0f + erff(v1[j] * 0.70710678f)); } }
                    u32x4 w; w.x = cvt_pk_bf16(v0[0], v0[1]); w.y = cvt_pk_bf16(v0[2], v0[3]); w.z = cvt_pk_bf16(v1[0], v1[1]); w.w = cvt_pk_bf16(v1[2], v1[3]);
                    *(u32x4*)(rowp + bj * HALF) = w; } }
    }
};

struct PanelStats {
    unsigned* xbuf;
    unsigned* cnt;
    unsigned* tmo;
    int ntn; float eps;
    unsigned code;
    __device__ __forceinline__ bool run(const f32x4 (&v)[2][2][4][2], const Unit& u, int wr, int wc, int fr, int fq, PG8_LAS unsigned char* lds, int wid, int lane) const {
        typedef float f32x2v __attribute__((ext_vector_type(2)));
        PG8_LAS f32x2v* P = (PG8_LAS f32x2v*)lds;
        PG8_LAS f32x2v* S = (PG8_LAS f32x2v*)(lds + 8192);
        PG8_LAS unsigned* flag = (PG8_LAS unsigned*)(lds + 8192 + 2048);
#pragma unroll
        for (int ai = 0; ai < 2; ++ai)
#pragma unroll
            for (int m = 0; m < 4; ++m) {
                float s = 0.f;
#pragma unroll
                for (int bj = 0; bj < 2; ++bj)
#pragma unroll
                    for (int n = 0; n < 2; ++n) { const f32x4 x = v[ai][bj][m][n]; s += (x[0] + x[1]) + (x[2] + x[3]); }
                s += __shfl_xor(s, 16); s += __shfl_xor(s, 32);
                const float mw = s * (1.0f / 64.0f); float q = 0.f;
#pragma unroll
                for (int bj = 0; bj < 2; ++bj)
#pragma unroll
                    for (int n = 0; n < 2; ++n) { const f32x4 d = v[ai][bj][m][n] - mw; q += (d[0] * d[0] + d[1] * d[1]) + (d[2] * d[2] + d[3] * d[3]); }
                q += __shfl_xor(q, 16); q += __shfl_xor(q, 32);
                if (fq == 0) P[(ai * HALF + wr * 64 + m * 16 + fr) * 4 + wc] = (f32x2v){mw, q};
            }
        asm volatile("s_waitcnt lgkmcnt(0)" ::: "memory"); __builtin_amdgcn_s_barrier(); asm volatile("" ::: "memory");
#if defined(BROKEN_NO_WAIT)
        if (blockIdx.x >= 64) { const long long t0 = clock64(); while (clock64() - t0 < 60000) __builtin_amdgcn_s_sleep(8); }
#endif
        const int row = wid * 32 + (lane & 31);
        if (lane < 32) {
            const f32x2v a = P[row * 4 + 0], b = P[row * 4 + 1], c = P[row * 4 + 2], d = P[row * 4 + 3];
            const float mt = (a.x + b.x + c.x + d.x) * 0.25f;
            const float da = a.x - mt, db = b.x - mt, dc = c.x - mt, dd = d.x - mt;
            const float m2 = (a.y + b.y) + (c.y + d.y) + 64.0f * ((da * da + db * db) + (dc * dc + dd * dd));
            unsigned long long* slot = (unsigned long long*)xbuf + ((size_t)(u.pm * BM + row) * 4 + u.pn);
            __hip_atomic_store(slot, ((unsigned long long)__float_as_uint(m2) << 32) | __float_as_uint(mt), __ATOMIC_RELAXED, __HIP_MEMORY_SCOPE_AGENT);
        }
        asm volatile("s_waitcnt vmcnt(0)" ::: "memory");
        if (lane == 0) __hip_atomic_fetch_add(cnt + 64 * u.pm, 1u, __ATOMIC_RELAXED, __HIP_MEMORY_SCOPE_AGENT);
        if (wid == 0) {
            bool dead = false; const unsigned long long t0 = __builtin_amdgcn_s_memrealtime(); const unsigned want = 8u * (unsigned)ntn;
            for (;;) {
#if defined(BROKEN_NO_WAIT)
                break;
#endif
                if ((unsigned)__builtin_amdgcn_readfirstlane(__hip_atomic_load(cnt + 64 * u.pm, __ATOMIC_RELAXED, __HIP_MEMORY_SCOPE_AGENT)) >= want) break;
                if (__builtin_amdgcn_s_memrealtime() - t0 > 2000000ull) {
                    if (lane == 0) { unsigned expect = 0u; __hip_atomic_compare_exchange_strong(tmo + 1, &expect, code | (unsigned)(u.pm & 0xff), __ATOMIC_RELAXED, __ATOMIC_RELAXED, __HIP_MEMORY_SCOPE_AGENT);
                                     __hip_atomic_store(tmo, 1u, __ATOMIC_RELAXED, __HIP_MEMORY_SCOPE_AGENT); }
                    dead = true; break; }
                __builtin_amdgcn_s_sleep(2);
            }
            __builtin_amdgcn_fence(__ATOMIC_ACQUIRE, "agent");
            if (lane == 0) flag[0] = dead ? 1u : 0u;
        }
        asm volatile("s_waitcnt vmcnt(0) lgkmcnt(0)" ::: "memory"); __builtin_amdgcn_s_barrier(); asm volatile("" ::: "memory");
        const bool bad = flag[0] != 0u;
        if (lane < 32) {
            const unsigned long long* slot = (const unsigned long long*)xbuf + (size_t)(u.pm * BM + row) * 4; float mt[4], m2[4]; float ms = 0.f;
#pragma unroll
            for (int t = 0; t < 4; ++t) { if (t < ntn) { const unsigned long long w = __hip_atomic_load(slot + t, __ATOMIC_RELAXED, __HIP_MEMORY_SCOPE_AGENT); mt[t] = __uint_as_float((unsigned)w); m2[t] = __uint_as_float((unsigned)(w >> 32)); } else { mt[t] = 0.f; m2[t] = 0.f; } ms += mt[t]; }
            const float mean = ms / (float)ntn; float q = 0.f;
#pragma unroll
            for (int t = 0; t < 4; ++t) if (t < ntn) { const float dm = mt[t] - mean; q += m2[t] + 256.0f * dm * dm; }
            S[row] = (f32x2v){mean, 1.0f / sqrtf(q / (256.0f * (float)ntn) + eps)};
        }
        asm volatile("s_waitcnt lgkmcnt(0)" ::: "memory"); __builtin_amdgcn_s_barrier(); asm volatile("" ::: "memory");
        return bad;
    }
};
struct EpiLnRes {
    static constexpr bool PERM = false, AFTER_DRAIN = true;
    const float* base; float* out; int ldc; const float* bias; PanelStats st; unsigned poison;
    __device__ __forceinline__ void refuse(size_t i0, size_t stride, int M, int N) const { const float q = __builtin_nanf(""); for (size_t i = i0; i < (size_t)M * N; i += stride) out[(i / N) * ldc + i % N] = q;
        if (i0 == 0) { unsigned expect = 0u; __hip_atomic_compare_exchange_strong(st.tmo + 1, &expect, 0x7f0u, __ATOMIC_RELAXED, __ATOMIC_RELAXED, __HIP_MEMORY_SCOPE_AGENT); __hip_atomic_store(st.tmo, 1u, __ATOMIC_RELAXED, __HIP_MEMORY_SCOPE_AGENT); } }
    __device__ __forceinline__ void fused(f32x4 (&acc)[2][2][4][2], const Unit& u, int wr, int wc, int fr, int fq, PG8_LAS unsigned char* lds, int wid, int lane) const {
        typedef float f32x2v __attribute__((ext_vector_type(2)));
        const PG8_LAS f32x2v* S = (const PG8_LAS f32x2v*)(lds + 8192);
        const int col0 = u.pn * BM + wc * 32 + 4 * fq;
#pragma unroll
        for (int bj = 0; bj < 2; ++bj)
#pragma unroll
            for (int n = 0; n < 2; ++n) { const f32x4 bv = bias ? *(const f32x4*)(bias + col0 + bj * HALF + n * 16) : (f32x4){0.f, 0.f, 0.f, 0.f};
#pragma unroll
                for (int ai = 0; ai < 2; ++ai)
#pragma unroll
                    for (int m = 0; m < 4; ++m) acc[ai][bj][m][n] += bv; }
        const bool bad = st.run(acc, u, wr, wc, fr, fq, lds, wid, lane) || poison != 0u;
        const float qnan = __builtin_nanf("");
#pragma unroll
        for (int ai = 0; ai < 2; ++ai)
#pragma unroll
            for (int m = 0; m < 4; ++m) { const int r = ai * HALF + wr * 64 + m * 16 + fr; const f32x2v sr = S[r]; const size_t off = (size_t)(u.pm * BM + r) * ldc + col0;
#pragma unroll
                for (int bj = 0; bj < 2; ++bj)
#pragma unroll
                    for (int n = 0; n < 2; ++n) { const f32x4 bs = *(const f32x4*)(base + off + bj * HALF + n * 16); f32x4 o = bs + (acc[ai][bj][m][n] - sr.x) * sr.y;
                        if (bad) o = (f32x4){qnan, qnan, qnan, qnan}; *(f32x4*)(out + off + bj * HALF + n * 16) = o; }
                asm volatile("" ::: "memory"); }
    }
};
struct EpiLnResLn {
    static constexpr bool PERM = false, AFTER_DRAIN = true;
    const float* base; float* out; bf16_t* xn; int ldc; const float* bias; PanelStats st1, st2; unsigned poison;
    __device__ __forceinline__ void refuse(size_t i0, size_t stride, int M, int N) const { const float q = __builtin_nanf(""); for (size_t i = i0; i < (size_t)M * N; i += stride) { const size_t o = (i / N) * ldc + i % N; out[o] = q; xn[o] = (bf16_t)0x7fc0u; }
        if (i0 == 0) { unsigned expect = 0u; __hip_atomic_compare_exchange_strong(st1.tmo + 1, &expect, 0x7f0u, __ATOMIC_RELAXED, __ATOMIC_RELAXED, __HIP_MEMORY_SCOPE_AGENT); __hip_atomic_store(st1.tmo, 1u, __ATOMIC_RELAXED, __HIP_MEMORY_SCOPE_AGENT); } }
    __device__ __forceinline__ void fused(f32x4 (&acc)[2][2][4][2], const Unit& u, int wr, int wc, int fr, int fq, PG8_LAS unsigned char* lds, int wid, int lane) const {
        typedef float f32x2v __attribute__((ext_vector_type(2))); typedef unsigned u32x2v __attribute__((ext_vector_type(2)));
        const PG8_LAS f32x2v* S = (const PG8_LAS f32x2v*)(lds + 8192);
        const int col0 = u.pn * BM + wc * 32 + 4 * fq;
#pragma unroll
        for (int bj = 0; bj < 2; ++bj)
#pragma unroll
            for (int n = 0; n < 2; ++n) { const f32x4 bv = bias ? *(const f32x4*)(bias + col0 + bj * HALF + n * 16) : (f32x4){0.f, 0.f, 0.f, 0.f};
#pragma unroll
                for (int ai = 0; ai < 2; ++ai)
#pragma unroll
                    for (int m = 0; m < 4; ++m) acc[ai][bj][m][n] += bv; }
        bool bad = st1.run(acc, u, wr, wc, fr, fq, lds, wid, lane) || poison != 0u;
        const float qnan = __builtin_nanf("");
#pragma unroll
        for (int ai = 0; ai < 2; ++ai)
#pragma unroll
            for (int m = 0; m < 4; ++m) { const int r = ai * HALF + wr * 64 + m * 16 + fr; const f32x2v sr = S[r]; const size_t off = (size_t)(u.pm * BM + r) * ldc + col0;
#pragma unroll
                for (int bj = 0; bj < 2; ++bj)
#pragma unroll
                    for (int n = 0; n < 2; ++n) { const f32x4 bs = *(const f32x4*)(base + off + bj * HALF + n * 16); acc[ai][bj][m][n] = bs + (acc[ai][bj][m][n] - sr.x) * sr.y; }
                asm volatile("" : "+v"(acc[ai][0][m][0]), "+v"(acc[ai][0][m][1]), "+v"(acc[ai][1][m][0]), "+v"(acc[ai][1][m][1]));
                if (m & 1) asm volatile("" ::: "memory"); }
        const bool bad1 = bad;
        bad = st2.run(acc, u, wr, wc, fr, fq, lds, wid, lane) || bad;
#pragma unroll
        for (int ai = 0; ai < 2; ++ai)
#pragma unroll
            for (int m = 0; m < 4; ++m) { const int r = ai * HALF + wr * 64 + m * 16 + fr; const f32x2v sr = S[r]; const size_t off = (size_t)(u.pm * BM + r) * ldc + col0;
#pragma unroll
                for (int bj = 0; bj < 2; ++bj)
#pragma unroll
                    for (int n = 0; n < 2; ++n) { const f32x4 x1 = acc[ai][bj][m][n]; *(f32x4*)(out + off + bj * HALF + n * 16) = bad1 ? (f32x4){qnan, qnan, qnan, qnan} : x1;
                        const f32x4 o = (x1 - sr.x) * sr.y; u32x2v w; w.x = cvt_pk_bf16(o[0], o[1]); w.y = cvt_pk_bf16(o[2], o[3]);
                        if (bad) { w.x = 0x7fc07fc0u; w.y = 0x7fc07fc0u; } *(u32x2v*)(xn + off + bj * HALF + n * 16) = w; }
                asm volatile("" ::: "memory"); }
    }
};

template <class Epi, class Sched, bool STAMP = false>
__device__ __forceinline__ void gemm_phase(PG8_LAS unsigned char* lds, const Gemm g, const Sched& S, const Epi& E, unsigned long long* stamps) {
    int tid_o = threadIdx.x; asm volatile("" : "+v"(tid_o)); const int tid = tid_o, wid = __builtin_amdgcn_readfirstlane(tid >> 6), lane = tid & 63, wr = wid >> 2, wc = wid & 3, fr = lane & 15, fq = lane >> 4;
    const int K = g.K, nt = K / BK;
    int ts_lo = 0, ts_hi = 0, nts = 0; const unsigned long long rt_entry = STAMP ? (unsigned long long)wall_clock64() : 0ull;
#define PG8_STAMP() do { if (STAMP && wid == 0 && nts < 64) { const unsigned long long _c = (unsigned long long)clock64(); \
        ts_lo = (lane == nts) ? (int)(unsigned)_c : ts_lo; ts_hi = (lane == nts) ? (int)(unsigned)(_c >> 32) : ts_hi; ++nts; } } while (0)
    PG8_STAMP();
    unsigned voffA[2], voffB[2];
#pragma unroll
    for (int i = 0; i < 2; ++i) { int R, C; stage_rc(tid * 16 + i * 8192, R, C); const int Rb = Epi::PERM ? ((R & ~31) + perm32(R & 31)) : R;
        voffA[i] = (unsigned)(R * K + C) * 2u; voffB[i] = (unsigned)(Rb * K + C) * 2u; }
    const size_t kstep = (size_t)(BK * 2);
    const size_t hstep = (size_t)HALF * K * 2;
    const size_t tstep = 2 * hstep;
    const unsigned ldsw = (unsigned)wid * 1024u;
    const int aoff = lds_byte(wr * 64 + fr, fq * 8), boff = lds_byte(wc * 32 + fr, fq * 8);
#define PG8_SA(b, h) (((b) * 2 + (h)) * HTB)
#define PG8_SB(b, h) ((4 + (b) * 2 + (h)) * HTB)
#define PG8_STAGE(bufoff, gbase, voff) do { _Pragma("unroll") for (int _i = 0; _i < 2; ++_i) \
        __builtin_amdgcn_global_load_lds((const unsigned*)((const char*)(gbase) + (voff)[_i]), (PG8_LAS unsigned*)(lds + (bufoff) + ldsw + _i * 8192), 16, 0, 0); } while (0)
#define PG8_LDA(dst, b, h) do { _Pragma("unroll") for (int m = 0; m < 4; ++m) _Pragma("unroll") for (int k = 0; k < 2; ++k) dst[m][k] = *(const PG8_LAS bf16x8*)(lds + PG8_SA(b, h) + aoff + m * 2048 + k * 1024); } while (0)
#define PG8_LDB(dst, b, h) do { _Pragma("unroll") for (int n = 0; n < 2; ++n) _Pragma("unroll") for (int k = 0; k < 2; ++k) dst[n][k] = *(const PG8_LAS bf16x8*)(lds + PG8_SB(b, h) + boff + n * 2048 + k * 1024); } while (0)
#define PG8_MMA(ai, bj, At, Bt) do { __builtin_amdgcn_s_setprio(1); _Pragma("unroll") for (int m = 0; m < 4; ++m) _Pragma("unroll") for (int n = 0; n < 2; ++n) _Pragma("unroll") for (int k = 0; k < 2; ++k) \
        acc[ai][bj][m][n] = __builtin_amdgcn_mfma_f32_16x16x32_bf16(Bt[n][k], At[m][k], acc[ai][bj][m][n], 0, 0, 0); __builtin_amdgcn_s_setprio(0); } while (0)
#define PG8_WAIT_V(n) asm volatile("s_waitcnt vmcnt(" #n ")" ::: "memory")
#define PG8_WAIT_L(n) asm volatile("s_waitcnt lgkmcnt(" #n ")" ::: "memory")
#define PG8_BAR __builtin_amdgcn_s_barrier()
#define PG8_SCHED __builtin_amdgcn_sched_barrier(0)
    Unit cur, nxt; int ui = 0;
    if (!S.next(0, cur)) return;
    f32x4 acc[2][2][4][2];
#pragma unroll
    for (int a = 0; a < 2; ++a)
#pragma unroll
        for (int b = 0; b < 2; ++b)
#pragma unroll
            for (int m = 0; m < 4; ++m)
#pragma unroll
                for (int n = 0; n < 2; ++n) acc[a][b][m][n] = (f32x4){0.f, 0.f, 0.f, 0.f};
    bf16x8 At[4][2], B0[2][2], B1[2][2];
    const char* cA = (const char*)g.A + (size_t)cur.pm * tstep; const char* cB = (const char*)g.Bt + (size_t)cur.pn * tstep;
    S.a_ready(cur);
    PG8_STAGE(PG8_SB(0, 0), cB, voffB); PG8_STAGE(PG8_SA(0, 0), cA, voffA); PG8_STAGE(PG8_SB(0, 1), cB + hstep, voffB); PG8_STAGE(PG8_SA(0, 1), cA + hstep, voffA);
    if (wr == 1) PG8_BAR;
    PG8_WAIT_V(4); PG8_BAR;
    PG8_STAGE(PG8_SB(1, 0), cB + kstep, voffB); PG8_STAGE(PG8_SA(1, 0), cA + kstep, voffA); PG8_STAGE(PG8_SB(1, 1), cB + hstep + kstep, voffB);
    PG8_WAIT_V(6); PG8_BAR;
    PG8_STAMP();
    for (;;) {
        const bool has_next = S.next(ui + 1, nxt);
        const char* nA = has_next ? (const char*)g.A + (size_t)nxt.pm * tstep : cA; const char* nB = has_next ? (const char*)g.Bt + (size_t)nxt.pn * tstep : cB;
        for (int t = 0; t < nt; t += 2) {
            const bool last = (t == nt - 2);
            const char* a1 = cA + (size_t)(t + 1) * kstep;
            const char* a2 = last ? nA : cA + (size_t)(t + 2) * kstep; const char* b2 = last ? nB : cB + (size_t)(t + 2) * kstep;
            const char* a3 = a2 + kstep; const char* b3 = b2 + kstep;
            if (last && has_next) S.a_ready(nxt);
            PG8_LDB(B0, 0, 0); PG8_SCHED; PG8_LDA(At, 0, 0); PG8_STAGE(PG8_SA(1, 1), a1 + hstep, voffA);
            PG8_WAIT_L(8); PG8_BAR; PG8_WAIT_L(0); PG8_MMA(0, 0, At, B0); PG8_BAR; PG8_SCHED;
            PG8_LDB(B1, 0, 1); PG8_STAGE(PG8_SB(0, 0), b2, voffB);
            PG8_BAR; PG8_WAIT_L(0); PG8_MMA(0, 1, At, B1); PG8_BAR;
            PG8_LDA(At, 0, 1); PG8_STAGE(PG8_SA(0, 0), a2, voffA);
            PG8_BAR; PG8_WAIT_L(0); PG8_MMA(1, 0, At, B0); PG8_BAR; PG8_SCHED;
            PG8_STAGE(PG8_SB(0, 1), b2 + hstep, voffB);
            PG8_WAIT_V(6); PG8_BAR; PG8_MMA(1, 1, At, B1); PG8_BAR;
            PG8_LDB(B0, 1, 0); PG8_SCHED; PG8_LDA(At, 1, 0); PG8_STAGE(PG8_SA(0, 1), a2 + hstep, voffA);
            PG8_WAIT_L(8); PG8_BAR; PG8_WAIT_L(0); PG8_MMA(0, 0, At, B0); PG8_BAR; PG8_SCHED;
            PG8_LDB(B1, 1, 1); PG8_STAGE(PG8_SB(1, 0), b3, voffB);
            PG8_BAR; PG8_WAIT_L(0); PG8_MMA(0, 1, At, B1); PG8_BAR;
            PG8_LDA(At, 1, 1); PG8_STAGE(PG8_SA(1, 0), a3, voffA);
            PG8_BAR; PG8_WAIT_L(0); PG8_MMA(1, 0, At, B0); PG8_BAR; PG8_SCHED;
            PG8_STAGE(PG8_SB(1, 1), b3 + hstep, voffB);
            PG8_WAIT_V(6); PG8_BAR; PG8_MMA(1, 1, At, B1); PG8_BAR;
        }
        PG8_STAMP();
        if constexpr (!Epi::AFTER_DRAIN) { E(acc, cur, wr, wc, fr, fq); S.done(cur); }
        PG8_STAMP();
        if (!has_next) break;
#pragma unroll
        for (int a = 0; a < 2; ++a)
#pragma unroll
            for (int b = 0; b < 2; ++b)
#pragma unroll
                for (int m = 0; m < 4; ++m)
#pragma unroll
                    for (int n = 0; n < 2; ++n) acc[a][b][m][n] = (f32x4){0.f, 0.f, 0.f, 0.f};
        cur = nxt; cA = nA; cB = nB; ++ui;
    }
    PG8_WAIT_V(0);
    if (wr == 0) PG8_BAR;
    PG8_BAR;
    if constexpr (Epi::AFTER_DRAIN) { E.fused(acc, cur, wr, wc, fr, fq, lds, wid, lane); S.done(cur); }
    PG8_STAMP();
    if (STAMP && wid == 0) { stamps[lane] = lane < nts ? (((unsigned long long)(unsigned)ts_hi << 32) | (unsigned)ts_lo) : 0ull;
        if (lane == 62) stamps[62] = rt_entry; if (lane == 63) stamps[63] = (unsigned long long)wall_clock64(); }
#undef PG8_STAMP
#undef PG8_SA
#undef PG8_SB
#undef PG8_STAGE
#undef PG8_LDA
#undef PG8_LDB
#undef PG8_MMA
#undef PG8_WAIT_V
#undef PG8_WAIT_L
#undef PG8_BAR
#undef PG8_SCHED
}
}

#include <hip/hip_cooperative_groups.h>
#include <cstdio>
namespace cg = cooperative_groups;
#define LAS __attribute__((address_space(3)))
using pg8::bf16_t; using pg8::bf16x8; using pg8::f32x4; using pg8::u32x4; using pg8::cvt_pk_bf16;
typedef float f32x2 __attribute__((ext_vector_type(2)));
typedef unsigned u32x2 __attribute__((ext_vector_type(2)));

constexpr int NB = 8, TT = 4112, SEQL = 4096, NMETA = 16, DM = 1024, DFF = 2816, DEPTH = 4;
constexpr int MTOK = NB * TT;
constexpr int MP = 33024;
constexpr int LDP = 2816;
constexpr int DIN = 2832, NINP = 3072;
constexpr float ALPHA = 1.681792830507429f;
constexpr int NTHR = 512;
constexpr int LDS_BYTES = pg8::STAGE_BYTES;

constexpr size_t SZ_WGU = (size_t)5632 * 1024 * 2, SZ_WD = (size_t)1024 * 2816 * 2, SZ_WIN = (size_t)NINP * 1024 * 2, SZ_WOUT = (size_t)1024 * 1024 * 2;
constexpr size_t WO_GU0 = 0, WO_D0 = WO_GU0 + SZ_WGU, WO_GU1 = WO_D0 + SZ_WD, WO_D1 = WO_GU1 + SZ_WGU, WO_IN = WO_D1 + SZ_WD, WO_OUT = WO_IN + SZ_WIN, SZ_WSET = WO_OUT + SZ_WOUT;
constexpr size_t WS_WB = 0;
constexpr size_t WS_H = WS_WB + 2 * SZ_WSET;
constexpr size_t WS_HB = WS_H + (size_t)MP * DM * 4;
constexpr size_t WS_U = WS_HB + (size_t)MP * DM * 2;
constexpr size_t WS_SMALL = WS_U + (size_t)MP * LDP * 2;
constexpr size_t WS_END = WS_SMALL + (size_t)MP * 16 * 4;
constexpr size_t DO_MIXB = 0, DO_ODN = (size_t)MP * DM * 2;

struct Params { const float* in[26]; float* out; unsigned char* ws; };

__device__ __forceinline__ float bf_lo(unsigned u) { return __uint_as_float(u << 16); }
__device__ __forceinline__ float bf_hi(unsigned u) { return __uint_as_float(u & 0xffff0000u); }
__device__ __forceinline__ float sigmoidf_(float x) { return 1.f / (1.f + __expf(-x)); }
__device__ __forceinline__ float siluf_(float x) { return x / (1.f + __expf(-x)); }
__device__ __forceinline__ float softplusf_(float x) { return fmaxf(x, 0.f) + log1pf(expf(-fabsf(x))); }
__device__ __forceinline__ float gelu_tanhf_(float x) { const float z = 0.7978845608028654f * (x + 0.044715f * x * x * x); const float t = 1.f - 2.f / (1.f + __expf(2.f * z)); return 0.5f * x * (1.f + t); }
__device__ __forceinline__ int otid() { int t = threadIdx.x; asm volatile("" : "+v"(t)); return t; }
template <int CTRL> __device__ __forceinline__ float dpp_f(float x) { return __int_as_float(__builtin_amdgcn_update_dpp(0, __float_as_int(x), CTRL, 0xf, 0xf, false)); }
__device__ __forceinline__ float allreduce8(float x) { x += dpp_f<0xB1>(x); x += dpp_f<0x4E>(x); x += dpp_f<0x141>(x); return x; }
__device__ __forceinline__ float allreduce16(float x) { x = allreduce8(x); x += dpp_f<0x140>(x); return x; }

struct EpiSwiGLU {
    static constexpr bool PERM = false, AFTER_DRAIN = false;
    bf16_t* O;
    __device__ __forceinline__ void operator()(const f32x4 (&acc)[2][2][4][2], const pg8::Unit& u, int wr, int wc, int fr, int fq) const {
        const int row0 = u.pm * 256 + wr * 64 + fr, col = u.pn * 128 + wc * 32 + fq * 8;
#pragma unroll
        for (int ai = 0; ai < 2; ++ai)
#pragma unroll
            for (int m = 0; m < 4; ++m) {
                const f32x4 g0 = acc[ai][0][m][0], u0 = acc[ai][0][m][1], g1 = acc[ai][1][m][0], u1 = acc[ai][1][m][1];
                float v[8];
#pragma unroll
                for (int j = 0; j < 4; ++j) { v[j] = siluf_(g0[j]) * u0[j]; v[4 + j] = siluf_(g1[j]) * u1[j]; }
                u32x4 w; w.x = cvt_pk_bf16(v[0], v[1]); w.y = cvt_pk_bf16(v[2], v[3]); w.z = cvt_pk_bf16(v[4], v[5]); w.w = cvt_pk_bf16(v[6], v[7]);
                *(u32x4*)(O + (size_t)(row0 + ai * 128 + m * 16) * DFF + col) = w;
            }
    }
};
struct EpiResid {
    static constexpr bool PERM = false, AFTER_DRAIN = false;
    float* Hh; float scale;
    __device__ __forceinline__ void operator()(const f32x4 (&acc)[2][2][4][2], const pg8::Unit& u, int wr, int wc, int fr, int fq) const {
        const int row0 = u.pm * 256 + wr * 64 + fr, col0 = u.pn * 256 + wc * 32 + 4 * fq;
#pragma unroll
        for (int ai = 0; ai < 2; ++ai)
#pragma unroll
            for (int m = 0; m < 4; ++m) { float* rowp = Hh + (size_t)(row0 + ai * 128 + m * 16) * DM + col0;
#pragma unroll
                for (int bj = 0; bj < 2; ++bj)
#pragma unroll
                    for (int n = 0; n < 2; ++n) { float* p = rowp + bj * 128 + n * 16; const f32x4 h = *(const f32x4*)p; *(f32x4*)p = h * ALPHA + acc[ai][bj][m][n] * scale; } }
    }
};
struct EpiProj {
    static constexpr bool PERM = true, AFTER_DRAIN = false;
    bf16_t* P; float* Sm;
    __device__ __forceinline__ void operator()(const f32x4 (&acc)[2][2][4][2], const pg8::Unit& u, int wr, int wc, int fr, int fq) const {
        const int row0 = u.pm * 256 + wr * 64 + fr;
#pragma unroll
        for (int ai = 0; ai < 2; ++ai)
#pragma unroll
            for (int m = 0; m < 4; ++m) { const size_t row = (size_t)(row0 + ai * 128 + m * 16);
#pragma unroll
                for (int bj = 0; bj < 2; ++bj) { const int c0 = u.pn * 256 + bj * 128 + wc * 32 + 8 * fq; const f32x4 v0 = acc[ai][bj][m][0], v1 = acc[ai][bj][m][1];
                    if (c0 < LDP) { u32x4 w; w.x = cvt_pk_bf16(v0[0], v0[1]); w.y = cvt_pk_bf16(v0[2], v0[3]); w.z = cvt_pk_bf16(v1[0], v1[1]); w.w = cvt_pk_bf16(v1[2], v1[3]); *(u32x4*)(P + row * LDP + c0) = w; }
                    else if (c0 < DIN) { float* sp = Sm + row * 16 + (c0 - LDP); *(f32x4*)sp = v0; *(f32x4*)(sp + 4) = v1; } } }
    }
};

__device__ __forceinline__ int map_row(int mode, int n) {
    if (mode == 0) return n;
    if (mode == 1 || mode == 2) { const int pn = n >> 7, fl = n & 127; return 256 * pn + 128 * ((fl >> 2) & 1) + 32 * (fl >> 5) + 16 * (mode - 1) + 4 * ((fl >> 3) & 3) + (fl & 3); }
    if (n < 1792) return n;
    if (n < 1800) return 2816 + (n - 1792);
    if (n < 2568) return 1792 + (n - 1800);
    if (n < 2824) return 2560 + (n - 2568);
    return 2824 + (n - 2824);
}
__device__ __forceinline__ void convert_tile(LAS float* tl, const float* __restrict__ src, int K, int N, int kt, int nt, bf16_t* dst, int mode) {
    const int tid = otid();
    { const int n = nt * 64 + (tid & 63);
#pragma unroll
      for (int i = 0; i < 8; ++i) { const int kl = i * 8 + (tid >> 6); const float v = (n < N) ? src[(size_t)(kt * 64 + kl) * N + n] : 0.f; tl[(tid & 63) * 65 + kl] = v; } }
    __syncthreads();
    { const int nl = tid >> 3, k8 = (tid & 7) * 8, n = nt * 64 + nl;
      if (n < N) { const int dr = map_row(mode, n); float v[8];
#pragma unroll
        for (int e = 0; e < 8; ++e) v[e] = tl[nl * 65 + k8 + e];
        u32x4 w; w.x = cvt_pk_bf16(v[0], v[1]); w.y = cvt_pk_bf16(v[2], v[3]); w.z = cvt_pk_bf16(v[4], v[5]); w.w = cvt_pk_bf16(v[6], v[7]);
        *(u32x4*)(dst + (size_t)dr * K + kt * 64 + k8) = w; } }
    __syncthreads();
}
__device__ void convert_layer(const Params& p, LAS unsigned char* lds, int l, unsigned char* wset) {
    LAS float* tl = (LAS float*)lds;
    for (int tile = blockIdx.x; tile < 5200; tile += gridDim.x) {
        int id = tile;
        if (id < 4224) { const int mat = id / 704, r = id % 704; const int f = mat / 3, kind = mat % 3;
            if (kind < 2) { const float* src = p.in[4 + kind] + (size_t)(l * 2 + f) * DM * DFF; convert_tile(tl, src, DM, DFF, r / 44, r % 44, (bf16_t*)(wset + (f ? WO_GU1 : WO_GU0)), 1 + kind); }
            else { const float* src = p.in[6] + (size_t)(l * 2 + f) * DFF * DM; convert_tile(tl, src, DFF, DM, r / 16, r % 16, (bf16_t*)(wset + (f ? WO_D1 : WO_D0)), 0); } }
        else if (id < 4224 + 720) { id -= 4224; convert_tile(tl, p.in[7] + (size_t)l * DM * DIN, DM, DIN, id / 45, id % 45, (bf16_t*)(wset + WO_IN), 3); }
        else { id -= 4944; convert_tile(tl, p.in[25] + (size_t)l * DM * DM, DM, DM, id / 16, id % 16, (bf16_t*)(wset + WO_OUT), 0); }
    }
}

__device__ void build_h(const Params& p, float* H, bf16_t* HB) {
    const int tid = otid(); const int lane = tid & 63, wave = tid >> 6;
    for (int r = blockIdx.x * 8 + wave; r < MP; r += gridDim.x * 8) {
        const int b = r / TT, t = r - b * TT;
        const float* src = (r >= MTOK) ? nullptr : (t < NMETA ? p.in[1] + (size_t)t * DM : p.in[0] + ((size_t)b * SEQL + (t - NMETA)) * DM);
#pragma unroll
        for (int i = 0; i < 4; ++i) { const int c = lane * 4 + 256 * i; f32x4 v = {0.f, 0.f, 0.f, 0.f}; if (src) v = *(const f32x4*)(src + c);
            *(f32x4*)(H + (size_t)r * DM + c) = v; u32x2 w; w.x = cvt_pk_bf16(v[0], v[1]); w.y = cvt_pk_bf16(v[2], v[3]); *(u32x2*)(HB + (size_t)r * DM + c) = w; }
    }
}
__device__ void ln_phase(float* H, bf16_t* HB, const float* __restrict__ g, const float* __restrict__ bb, float* outp) {
    const int tid = otid(); const int lane = tid & 63, wave = tid >> 6;
    f32x4 gv[4], bv[4];
#pragma unroll
    for (int i = 0; i < 4; ++i) { gv[i] = *(const f32x4*)(g + lane * 4 + 256 * i); bv[i] = *(const f32x4*)(bb + lane * 4 + 256 * i); }
    for (int r = blockIdx.x * 8 + wave; r < MTOK; r += gridDim.x * 8) {
        f32x4 x[4]; float s = 0.f;
#pragma unroll
        for (int i = 0; i < 4; ++i) { x[i] = *(const f32x4*)(H + (size_t)r * DM + lane * 4 + 256 * i); s += (x[i][0] + x[i][1]) + (x[i][2] + x[i][3]); }
#pragma unroll
        for (int o = 32; o >= 1; o >>= 1) s += __shfl_xor(s, o);
        const float mu = s * (1.f / DM); float q = 0.f;
#pragma unroll
        for (int i = 0; i < 4; ++i) { x[i] = x[i] - mu; q += (x[i][0] * x[i][0] + x[i][1] * x[i][1]) + (x[i][2] * x[i][2] + x[i][3] * x[i][3]); }
#pragma unroll
        for (int o = 32; o >= 1; o >>= 1) q += __shfl_xor(q, o);
        const float rstd = rsqrtf(q * (1.f / DM) + 1e-5f);
        const int b = r / TT, t = r - b * TT;
#pragma unroll
        for (int i = 0; i < 4; ++i) { const int c = lane * 4 + 256 * i; const f32x4 y = x[i] * rstd * gv[i] + bv[i];
            if (outp) { if (t >= NMETA) *(f32x4*)(outp + ((size_t)b * SEQL + (t - NMETA)) * DM + c) = y; }
            else { *(f32x4*)(H + (size_t)r * DM + c) = y; u32x2 w; w.x = cvt_pk_bf16(y[0], y[1]); w.y = cvt_pk_bf16(y[2], y[3]); *(u32x2*)(HB + (size_t)r * DM + c) = w; } }
    }
}
__device__ void finalize_phase(const Params& p, int l, const bf16_t* PROJ, const float* OSSD, const float* ODN, bf16_t* MIXB) {
    const int tid = otid(); const int lane = tid & 63, wave = tid >> 6;
    float nws[8], nwd[4];
#pragma unroll
    for (int e = 0; e < 8; ++e) nws[e] = p.in[20][l * 512 + lane * 8 + e];
#pragma unroll
    for (int e = 0; e < 4; ++e) nwd[e] = p.in[24][l * 64 + (lane & 15) * 4 + e];
    for (int r = blockIdx.x * 8 + wave; r < MTOK; r += gridDim.x * 8) {
        {
            const f32x4 y0 = *(const f32x4*)(OSSD + (size_t)r * 512 + lane * 8), y1 = *(const f32x4*)(OSSD + (size_t)r * 512 + lane * 8 + 4);
            const u32x4 zr = *(const u32x4*)(PROJ + (size_t)r * LDP + 512 + lane * 8);
            float v[8]; const float z[8] = {bf_lo(zr.x), bf_hi(zr.x), bf_lo(zr.y), bf_hi(zr.y), bf_lo(zr.z), bf_hi(zr.z), bf_lo(zr.w), bf_hi(zr.w)};
            float ss = 0.f;
#pragma unroll
            for (int e = 0; e < 8; ++e) { const float yy = e < 4 ? y0[e & 3] : y1[e & 3]; v[e] = yy * siluf_(z[e]); ss += v[e] * v[e]; }
#pragma unroll
            for (int o = 16; o >= 1; o >>= 1) ss += __shfl_xor(ss, o);
            const float rs = rsqrtf(ss * (1.f / 256.f) + 1e-6f);
#pragma unroll
            for (int e = 0; e < 8; ++e) v[e] = v[e] * rs * nws[e];
            u32x4 w; w.x = cvt_pk_bf16(v[0], v[1]); w.y = cvt_pk_bf16(v[2], v[3]); w.z = cvt_pk_bf16(v[4], v[5]); w.w = cvt_pk_bf16(v[6], v[7]);
            *(u32x4*)(MIXB + (size_t)r * DM + 256 + lane * 8) = w;
        }
        {
            const f32x4 o = *(const f32x4*)(ODN + (size_t)r * 256 + lane * 4);
            const u32x2 gr = *(const u32x2*)(PROJ + (size_t)r * LDP + 2560 + lane * 4);
            const float gt[4] = {bf_lo(gr.x), bf_hi(gr.x), bf_lo(gr.y), bf_hi(gr.y)};
            float ss = (o[0] * o[0] + o[1] * o[1]) + (o[2] * o[2] + o[3] * o[3]);
#pragma unroll
            for (int k = 8; k >= 1; k >>= 1) ss += __shfl_xor(ss, k);
            const float rs = rsqrtf(ss * (1.f / 64.f) + 1e-6f);
            float v[4];
#pragma unroll
            for (int e = 0; e < 4; ++e) v[e] = o[e] * rs * nwd[e] * siluf_(gt[e]);
            u32x2 w; w.x = cvt_pk_bf16(v[0], v[1]); w.y = cvt_pk_bf16(v[2], v[3]);
            *(u32x2*)(MIXB + (size_t)r * DM + 768 + lane * 4) = w;
        }
    }
    for (int i = blockIdx.x * NTHR + tid; i < (MP - MTOK) * DM / 8; i += gridDim.x * NTHR) { u32x4 z = {0u, 0u, 0u, 0u}; *(u32x4*)(MIXB + (size_t)MTOK * DM + (size_t)i * 8) = z; }
}

struct Raw8 { u32x4 r[4]; };
struct Raw4 { u32x2 r[4]; };
__device__ __forceinline__ void load_raw8(Raw8& R, const bf16_t* pb, int t, int col, bool valid) {
#pragma unroll
    for (int j = 0; j < 4; ++j) { const int tt = t - 3 + j; u32x4 z = {0u, 0u, 0u, 0u}; if (valid && tt >= 0) z = *(const u32x4*)(pb + (size_t)tt * LDP + col); R.r[j] = z; }
}
__device__ __forceinline__ void load_raw4(Raw4& R, const bf16_t* pb, int t, int col, bool valid) {
#pragma unroll
    for (int j = 0; j < 4; ++j) { const int tt = t - 3 + j; u32x2 z = {0u, 0u}; if (valid && tt >= 0) z = *(const u32x2*)(pb + (size_t)tt * LDP + col); R.r[j] = z; }
}
__device__ __forceinline__ void conv8(const Raw8& R, const float* __restrict__ cw, int C, int cc, const float* __restrict__ cb, float (&out)[8]) {
#pragma unroll
    for (int e = 0; e < 8; ++e) out[e] = cb ? cb[cc + e] : 0.f;
#pragma unroll
    for (int j = 0; j < 4; ++j) { const f32x4 w0 = *(const f32x4*)(cw + j * C + cc), w1 = *(const f32x4*)(cw + j * C + cc + 4); const u32x4 x = R.r[j];
        out[0] += w0[0] * bf_lo(x.x); out[1] += w0[1] * bf_hi(x.x); out[2] += w0[2] * bf_lo(x.y); out[3] += w0[3] * bf_hi(x.y);
        out[4] += w1[0] * bf_lo(x.z); out[5] += w1[1] * bf_hi(x.z); out[6] += w1[2] * bf_lo(x.w); out[7] += w1[3] * bf_hi(x.w); }
}
__device__ __forceinline__ void conv4(const Raw4& R, const float* __restrict__ cw, int C, int cc, const float* __restrict__ cb, float (&out)[4]) {
#pragma unroll
    for (int e = 0; e < 4; ++e) out[e] = cb ? cb[cc + e] : 0.f;
#pragma unroll
    for (int j = 0; j < 4; ++j) { const f32x4 w0 = *(const f32x4*)(cw + j * C + cc); const u32x2 x = R.r[j];
        out[0] += w0[0] * bf_lo(x.x); out[1] += w0[1] * bf_hi(x.x); out[2] += w0[2] * bf_lo(x.y); out[3] += w0[3] * bf_hi(x.y); }
}

__device__ void dn_task(const Params& p, LAS unsigned char* lds, int l, int b, int h, int cgp, const bf16_t* PROJ, const float* SMALL, float* ODN) {
    LAS f32x4* Kp = (LAS f32x4*)lds;
    LAS f32x4* Qp = (LAS f32x4*)(lds + 16384);
    LAS float* Vp = (LAS float*)(lds + 32768);
    LAS float* Op = (LAS float*)(lds + 40960);
    LAS f32x2* EB = (LAS f32x2*)(lds + 49152);
    const int tid = otid(), tok = tid >> 3, part = tid & 7, j = tid >> 4, s = tid & 15;
    const bf16_t* pb = PROJ + (size_t)b * TT * LDP;
    const float* sb = SMALL + (size_t)b * TT * 16;
    const float* cw = p.in[21] + (size_t)l * 4 * 768;
    const int qc = h * 64 + part * 8, kc = 256 + h * 64 + part * 8, vc = 512 + h * 64 + cgp * 32 + part * 4;
    const float nega = -expf(p.in[22][l * 4 + h]), dtb = p.in[23][l * 4 + h];
    float S0 = 0.f, S1 = 0.f, S2 = 0.f, S3 = 0.f;
    Raw8 rq, rk; Raw4 rv;
    load_raw8(rq, pb, tok, 1792 + qc, true); load_raw8(rk, pb, tok, 1792 + kc, true); load_raw4(rv, pb, tok, 1792 + vc, true);
    for (int t0 = 0; t0 < TT; t0 += 64) {
        const int len = (TT - t0) < 64 ? (TT - t0) : 64;
        {   float q8[8], k8[8], v4[4];
            conv8(rq, cw, 768, qc, nullptr, q8); conv8(rk, cw, 768, kc, nullptr, k8); conv4(rv, cw, 768, vc, nullptr, v4);
            float sq = 0.f, sk = 0.f;
#pragma unroll
            for (int e = 0; e < 8; ++e) { q8[e] = siluf_(q8[e]); k8[e] = siluf_(k8[e]); sq += q8[e] * q8[e]; sk += k8[e] * k8[e]; }
            sq = allreduce8(sq); sk = allreduce8(sk);
            const float rq_ = rsqrtf(sq + 1e-6f) * 0.125f, rk_ = rsqrtf(sk + 1e-6f);
            f32x4 a0 = {q8[0] * rq_, q8[1] * rq_, q8[2] * rq_, q8[3] * rq_}, a1 = {q8[4] * rq_, q8[5] * rq_, q8[6] * rq_, q8[7] * rq_};
            f32x4 b0 = {k8[0] * rk_, k8[1] * rk_, k8[2] * rk_, k8[3] * rk_}, b1 = {k8[4] * rk_, k8[5] * rk_, k8[6] * rk_, k8[7] * rk_};
            Qp[tok * 16 + part * 2] = a0; Qp[tok * 16 + part * 2 + 1] = a1; Kp[tok * 16 + part * 2] = b0; Kp[tok * 16 + part * 2 + 1] = b1;
            f32x4 vv = {siluf_(v4[0]), siluf_(v4[1]), siluf_(v4[2]), siluf_(v4[3])};
            *(LAS f32x4*)(Vp + tok * 32 + part * 4) = vv;
            if (tid < 64) { f32x2 eb = {1.f, 0.f};
                if (tid < len) { const float* sp = sb + (size_t)(t0 + tid) * 16; const float g = nega * softplusf_(sp[12 + h] + dtb); eb.x = expf(g); eb.y = sigmoidf_(sp[8 + h]); }
                EB[tid] = eb; }
        }
        __syncthreads();
        if (t0 + 64 < TT) { const int tn = t0 + 64 + tok; const bool vld = tn < TT;
            load_raw8(rq, pb, tn, 1792 + qc, vld); load_raw8(rk, pb, tn, 1792 + kc, vld); load_raw4(rv, pb, tn, 1792 + vc, vld); }
        const int nblk = len >> 4;
        for (int i = 0; i < nblk; ++i) {
            float oreg = 0.f;
#pragma unroll
            for (int u = 0; u < 16; ++u) {
                const int t = i * 16 + u;
                const f32x4 kk = Kp[t * 16 + s], qq = Qp[t * 16 + s]; const f32x2 eb = EB[t]; const float vj = Vp[t * 32 + j];
                S0 *= eb.x; S1 *= eb.x; S2 *= eb.x; S3 *= eb.x;
                float r = (kk[0] * S0 + kk[1] * S1) + (kk[2] * S2 + kk[3] * S3);
                r = allreduce16(r);
                const float vn = eb.y * (vj - r);
                S0 += kk[0] * vn; S1 += kk[1] * vn; S2 += kk[2] * vn; S3 += kk[3] * vn;
                float o = (qq[0] * S0 + qq[1] * S1) + (qq[2] * S2 + qq[3] * S3);
                o = allreduce16(o);
                oreg = (s == u) ? o : oreg;
            }
            Op[(i * 16 + s) * 32 + j] = oreg;
        }
        __syncthreads();
        if (tok < len) *(f32x4*)(ODN + ((size_t)b * TT + t0 + tok) * 256 + h * 64 + cgp * 32 + part * 4) = *(LAS f32x4*)(Op + tok * 32 + part * 4);
    }
    __syncthreads();
}

__device__ void ssd_task(const Params& p, LAS unsigned char* lds, int l, int b, int hd, int ph, const bf16_t* PROJ, const float* SMALL, float* OSSD) {
    LAS f32x4* Bp = (LAS f32x4*)lds;
    LAS f32x4* Cp = (LAS f32x4*)(lds + 16384);
    LAS float* Xp = (LAS float*)(lds + 32768);
    LAS float* Op = (LAS float*)(lds + 40960);
    LAS f32x2* DD = (LAS f32x2*)(lds + 49152);
    const int tid = otid(), tok = tid >> 3, part = tid & 7, pl = tid >> 4, n4 = tid & 15;
    const bf16_t* pb = PROJ + (size_t)b * TT * LDP;
    const float* sb = SMALL + (size_t)b * TT * 16;
    const float* cw = p.in[15] + (size_t)l * 4 * 768; const float* cb = p.in[16] + (size_t)l * 768;
    const int g = hd >> 2;
    const int bc = 512 + g * 64 + part * 8, cc = 640 + g * 64 + part * 8, xc = hd * 64 + ph * 32 + part * 4;
    const float nega = -expf(p.in[18][l * 8 + hd]), dtb = p.in[17][l * 8 + hd], Dh = p.in[19][l * 8 + hd];
    float S0 = 0.f, S1 = 0.f, S2 = 0.f, S3 = 0.f;
    Raw8 rb, rc; Raw4 rx;
    load_raw8(rb, pb, tok, 1024 + bc, true); load_raw8(rc, pb, tok, 1024 + cc, true); load_raw4(rx, pb, tok, 1024 + xc, true);
    for (int t0 = 0; t0 < TT; t0 += 64) {
        const int len = (TT - t0) < 64 ? (TT - t0) : 64;
        {   float b8[8], c8[8], x4[4];
            conv8(rb, cw, 768, bc, cb, b8); conv8(rc, cw, 768, cc, cb, c8); conv4(rx, cw, 768, xc, cb, x4);
#pragma unroll
            for (int e = 0; e < 8; ++e) { b8[e] = siluf_(b8[e]); c8[e] = siluf_(c8[e]); }
            f32x4 a0 = {b8[0], b8[1], b8[2], b8[3]}, a1 = {b8[4], b8[5], b8[6], b8[7]}, c0 = {c8[0], c8[1], c8[2], c8[3]}, c1 = {c8[4], c8[5], c8[6], c8[7]};
            Bp[tok * 16 + part * 2] = a0; Bp[tok * 16 + part * 2 + 1] = a1; Cp[tok * 16 + part * 2] = c0; Cp[tok * 16 + part * 2 + 1] = c1;
            f32x4 xv = {siluf_(x4[0]), siluf_(x4[1]), siluf_(x4[2]), siluf_(x4[3])};
            *(LAS f32x4*)(Xp + tok * 32 + part * 4) = xv;
            if (tid < 64) { f32x2 dd = {1.f, 0.f};
                if (tid < len) { const float dt = softplusf_(sb[(size_t)(t0 + tid) * 16 + hd] + dtb); dd.x = expf(dt * nega); dd.y = dt; }
                DD[tid] = dd; }
        }
        __syncthreads();
        if (t0 + 64 < TT) { const int tn = t0 + 64 + tok; const bool vld = tn < TT;
            load_raw8(rb, pb, tn, 1024 + bc, vld); load_raw8(rc, pb, tn, 1024 + cc, vld); load_raw4(rx, pb, tn, 1024 + xc, vld); }
        const int nblk = len >> 4;
        for (int i = 0; i < nblk; ++i) {
            float oreg = 0.f;
#pragma unroll
            for (int u = 0; u < 16; ++u) {
                const int t = i * 16 + u;
                const f32x4 Bv = Bp[t * 16 + n4], Cv = Cp[t * 16 + n4]; const f32x2 dd = DD[t]; const float xv = Xp[t * 32 + pl];
                const float xd = xv * dd.y;
                S0 = dd.x * S0 + xd * Bv[0]; S1 = dd.x * S1 + xd * Bv[1]; S2 = dd.x * S2 + xd * Bv[2]; S3 = dd.x * S3 + xd * Bv[3];
                float y = (Cv[0] * S0 + Cv[1] * S1) + (Cv[2] * S2 + Cv[3] * S3);
                y = allreduce16(y);
                y += Dh * xv;
                oreg = (n4 == u) ? y : oreg;
            }
            Op[(i * 16 + n4) * 32 + pl] = oreg;
        }
        __syncthreads();
        if (tok < len) *(f32x4*)(OSSD + ((size_t)b * TT + t0 + tok) * 512 + hd * 64 + ph * 32 + part * 4) = *(LAS f32x4*)(Op + tok * 32 + part * 4);
    }
    __syncthreads();
}

__device__ void lru_task(const Params& p, LAS unsigned char* lds, int l, int b, int hd, const bf16_t* PROJ, bf16_t* MIXB) {
    LAS float* Uf = (LAS float*)lds;
    LAS float* Yg = (LAS float*)(lds + 16384);
    LAS float* Ap = (LAS float*)(lds + 32768);
    LAS float* Mp = (LAS float*)(lds + 49152);
    LAS float* Ip = (LAS float*)(lds + 65536);
    LAS bf16_t* Ub = (LAS bf16_t*)(lds + 81920);
    LAS float* SegP = (LAS float*)(lds + 91136);
    LAS float* SegH = (LAS float*)(lds + 93184);
    LAS float* Hst = (LAS float*)(lds + 95232);
    LAS bf16_t* Ob = (LAS bf16_t*)(lds + 95488);
    const int tid = otid(), tok = tid >> 3, part = tid & 7, lane = tid & 63, wave = tid >> 6, fr = lane & 15, fq = lane >> 4;
    const bf16_t* pb = PROJ + (size_t)b * TT * LDP;
    const float* cw = p.in[8] + (size_t)l * 4 * 256; const float* cb = p.in[9] + (size_t)l * 256;
    const int uc = hd * 64 + part * 8;
    const int gt = wave >> 2, cbk = wave & 3, och = cbk * 16 + fr;
    const float* W = p.in[gt ? 12 : 10] + (size_t)(l * 4 + hd) * 64 * 64;
    bf16x8 bfrag[2];
#pragma unroll
    for (int ks = 0; ks < 2; ++ks) { float w[8];
#pragma unroll
        for (int e = 0; e < 8; ++e) w[e] = W[(ks * 32 + 8 * fq + e) * 64 + och];
        u32x4 pk; pk.x = cvt_pk_bf16(w[0], w[1]); pk.y = cvt_pk_bf16(w[2], w[3]); pk.z = cvt_pk_bf16(w[4], w[5]); pk.w = cvt_pk_bf16(w[6], w[7]);
        bfrag[ks] = __builtin_bit_cast(bf16x8, pk); }
    const float gbias = p.in[gt ? 13 : 11][l * 256 + hd * 64 + och];
    const float c8 = -8.f * softplusf_(-p.in[14][l * 256 + hd * 64 + och]);
    if (tid < 64) Hst[tid] = 0.f;
    Raw8 ru; u32x4 ry;
    load_raw8(ru, pb, tok, uc, true); ry = *(const u32x4*)(pb + (size_t)tok * LDP + 256 + uc);
    const int ch = tid & 63, seg = tid >> 6;
    for (int t0 = 0; t0 < TT; t0 += 64) {
        const int len = (TT - t0) < 64 ? (TT - t0) : 64;
        {   float u8[8]; conv8(ru, cw, 256, uc, cb, u8);
            if (tok >= len) {
#pragma unroll
                for (int e = 0; e < 8; ++e) u8[e] = 0.f; }
            f32x4 a0 = {u8[0], u8[1], u8[2], u8[3]}, a1 = {u8[4], u8[5], u8[6], u8[7]};
            *(LAS f32x4*)(Uf + tok * 64 + part * 8) = a0; *(LAS f32x4*)(Uf + tok * 64 + part * 8 + 4) = a1;
            u32x4 pk; pk.x = cvt_pk_bf16(u8[0], u8[1]); pk.y = cvt_pk_bf16(u8[2], u8[3]); pk.z = cvt_pk_bf16(u8[4], u8[5]); pk.w = cvt_pk_bf16(u8[6], u8[7]);
            *(LAS u32x4*)(Ub + tok * 72 + part * 8) = pk;
            const float y[8] = {bf_lo(ry.x), bf_hi(ry.x), bf_lo(ry.y), bf_hi(ry.y), bf_lo(ry.z), bf_hi(ry.z), bf_lo(ry.w), bf_hi(ry.w)};
            f32x4 g0, g1;
#pragma unroll
            for (int e = 0; e < 4; ++e) { g0[e] = gelu_tanhf_(y[e]); g1[e] = gelu_tanhf_(y[4 + e]); }
            *(LAS f32x4*)(Yg + tok * 64 + part * 8) = g0; *(LAS f32x4*)(Yg + tok * 64 + part * 8 + 4) = g1;
        }
        __syncthreads();
        if (t0 + 64 < TT) { const int tn = t0 + 64 + tok; const bool vld = tn < TT;
            load_raw8(ru, pb, tn, uc, vld); u32x4 z = {0u, 0u, 0u, 0u}; if (vld) z = *(const u32x4*)(pb + (size_t)tn * LDP + 256 + uc); ry = z; }
#pragma unroll
        for (int m = 0; m < 4; ++m) {
            f32x4 acc = {0.f, 0.f, 0.f, 0.f};
#pragma unroll
            for (int ks = 0; ks < 2; ++ks) { const bf16x8 a = *(const LAS bf16x8*)(Ub + (16 * m + fr) * 72 + ks * 32 + 8 * fq); acc = __builtin_amdgcn_mfma_f32_16x16x32_bf16(a, bfrag[ks], acc, 0, 0, 0); }
#pragma unroll
            for (int jj = 0; jj < 4; ++jj) { const int tk = 16 * m + 4 * fq + jj; const float v = sigmoidf_(acc[jj] + gbias);
                if (gt == 0) { const float la = c8 * v; Ap[tk * 64 + och] = expf(la); Mp[tk * 64 + och] = sqrtf(-expm1f(2.f * la)); }
                else Ip[tk * 64 + och] = v; }
        }
        __syncthreads();
        float hl[8], plv[8];
        {   float hloc = 0.f, P = 1.f;
#pragma unroll
            for (int e = 0; e < 8; ++e) { const int t = seg * 8 + e; float a = Ap[t * 64 + ch], bb = Mp[t * 64 + ch] * Ip[t * 64 + ch] * Uf[t * 64 + ch];
                if (t >= len) { a = 1.f; bb = 0.f; }
                hloc = a * hloc + bb; P *= a; hl[e] = hloc; plv[e] = P; }
            SegP[seg * 64 + ch] = P; SegH[seg * 64 + ch] = hloc;
        }
        __syncthreads();
        float c = Hst[ch];
#pragma unroll
        for (int s2 = 0; s2 < 7; ++s2) if (s2 < seg) c = SegP[s2 * 64 + ch] * c + SegH[s2 * 64 + ch];
        float hlast = 0.f;
#pragma unroll
        for (int e = 0; e < 8; ++e) { const int t = seg * 8 + e; const float hh = hl[e] + plv[e] * c; hlast = hh; const float o = hh * Yg[t * 64 + ch];
            Ob[t * 64 + ch] = (bf16_t)(cvt_pk_bf16(o, 0.f) & 0xffffu); }
        __syncthreads();
        if (seg == 7) Hst[ch] = hlast;
        if (tok < len) *(u32x4*)(MIXB + ((size_t)b * TT + t0 + tok) * DM + hd * 64 + part * 8) = *(const LAS u32x4*)(Ob + tok * 64 + part * 8);
    }
    __syncthreads();
}

__device__ void mixer_phase(const Params& p, LAS unsigned char* lds, int l, const bf16_t* PROJ, const float* SMALL, float* OSSD, float* ODN, bf16_t* MIXB) {
    for (int task = blockIdx.x; task < 224; task += gridDim.x) {
        if (task < 64) {
#ifndef NO_DN
 const int b = task >> 3, h = (task >> 1) & 3, c2 = task & 1; dn_task(p, lds, l, b, h, c2, PROJ, SMALL, ODN);
#endif
 }
        else if (task < 192) {
#ifndef NO_SSD
 const int k = task - 64; const int b = k >> 4, hd = (k >> 1) & 7, ph = k & 1; ssd_task(p, lds, l, b, hd, ph, PROJ, SMALL, OSSD);
#endif
 }
        else {
#ifndef NO_LRU
 const int k = task - 192; lru_task(p, lds, l, k >> 2, k & 3, PROJ, MIXB);
#endif
 }
    }
}

__global__ void __launch_bounds__(NTHR, 2) hymba_mega(Params p) {
    extern __shared__ __attribute__((aligned(16))) unsigned char lds_raw[];
    LAS unsigned char* lds = (LAS unsigned char*)lds_raw;
    cg::grid_group grid = cg::this_grid();
    unsigned char* ws = p.ws;
    float* H = (float*)(ws + WS_H); bf16_t* HB = (bf16_t*)(ws + WS_HB);
    bf16_t* ACT = (bf16_t*)(ws + WS_U); bf16_t* PROJ = (bf16_t*)(ws + WS_U); float* SMALL = (float*)(ws + WS_SMALL);
    float* OSSD = (float*)(ws + WS_HB);
    bf16_t* MIXB = (bf16_t*)((unsigned char*)p.out + DO_MIXB); float* ODN = (float*)((unsigned char*)p.out + DO_ODN);
    const int G = gridDim.x, c = blockIdx.x;

    build_h(p, H, HB);
    convert_layer(p, lds, 0, ws + WS_WB);
    grid.sync();
#pragma unroll 1
    for (int l = 0; l < DEPTH; ++l) {
        unsigned char* wset = ws + WS_WB + (size_t)(l & 1) * SZ_WSET;
#pragma unroll 1
        for (int f = 0; f < 2; ++f) {
            if (f == 1) {
                {   pg8::Gemm g{HB, (const bf16_t*)(wset + WO_IN), MP, NINP, DM}; pg8::StaticOrder S; S.init(MP, NINP, G, c);
                    EpiProj E{PROJ, SMALL}; pg8::gemm_phase<EpiProj, pg8::StaticOrder>(lds, g, S, E, nullptr); }
                grid.sync();
#ifndef NO_MIXER
                mixer_phase(p, lds, l, PROJ, SMALL, OSSD, ODN, MIXB);
#endif
                grid.sync();
                finalize_phase(p, l, PROJ, OSSD, ODN, MIXB);
                grid.sync();
                {   pg8::Gemm g{MIXB, (const bf16_t*)(wset + WO_OUT), MP, DM, DM}; pg8::StaticOrder S; S.init(MP, DM, G, c);
                    EpiResid E{H, 1.0f}; pg8::gemm_phase<EpiResid, pg8::StaticOrder>(lds, g, S, E, nullptr); }
                grid.sync();
                ln_phase(H, HB, p.in[2] + (size_t)(l * 3 + 1) * DM, p.in[3] + (size_t)(l * 3 + 1) * DM, nullptr);
                grid.sync();
            }
            {   pg8::Gemm g{HB, (const bf16_t*)(wset + (f ? WO_GU1 : WO_GU0)), MP, 2 * DFF, DM}; pg8::StaticOrder S; S.init(MP, 2 * DFF, G, c);
                EpiSwiGLU E{ACT}; pg8::gemm_phase<EpiSwiGLU, pg8::StaticOrder>(lds, g, S, E, nullptr); }
            grid.sync();
            {   pg8::Gemm g{ACT, (const bf16_t*)(wset + (f ? WO_D1 : WO_D0)), MP, DM, DFF}; pg8::StaticOrder S; S.init(MP, DM, G, c);
                EpiResid E{H, 0.5f}; pg8::gemm_phase<EpiResid, pg8::StaticOrder>(lds, g, S, E, nullptr); }
            grid.sync();
            const int li = l * 3 + (f ? 2 : 0);
            ln_phase(H, HB, p.in[2] + (size_t)li * DM, p.in[3] + (size_t)li * DM, (l == DEPTH - 1 && f == 1) ? p.out : nullptr);
            if (f == 0 && l + 1 < DEPTH) convert_layer(p, lds, l + 1, ws + WS_WB + (size_t)((l + 1) & 1) * SZ_WSET);
            grid.sync();
        }
    }
}

extern "C" void kernel_launch(void* const* d_in, const int* in_sizes, int n_in, void* d_out, int out_size, void* d_ws, size_t ws_size, hipStream_t stream) {
    static int grid_blocks = 0;
    if (!grid_blocks) {
        int dev = 0, cus = 0, per_cu = 0;
        hipGetDevice(&dev);
        hipDeviceGetAttribute(&cus, hipDeviceAttributeMultiprocessorCount, dev);
        hipFuncSetAttribute((const void*)hymba_mega, hipFuncAttributeMaxDynamicSharedMemorySize, LDS_BYTES);
        hipOccupancyMaxActiveBlocksPerMultiprocessor(&per_cu, (const void*)hymba_mega, NTHR, LDS_BYTES);
        if (per_cu < 1) per_cu = 1;
        grid_blocks = cus * per_cu;
        if (ws_size < WS_END) fprintf(stderr, "workspace too small: %zu < %zu\n", ws_size, (size_t)WS_END);
    }
    Params p{};
    for (int i = 0; i < 26; ++i) p.in[i] = (const float*)d_in[i];
    p.out = (float*)d_out; p.ws = (unsigned char*)d_ws;
    void* args[] = {&p};
    hipError_t e = hipLaunchCooperativeKernel((const void*)hymba_mega, dim3(grid_blocks), dim3(NTHR), args, LDS_BYTES, stream);
    if (e != hipSuccess) fprintf(stderr, "cooperative launch failed: %s (grid %d)\n", hipGetErrorString(e), grid_blocks);
}
```

```cpp
#define USE_CG_SYNC 1
#include <hip/hip_runtime.h>
namespace pg8 {
#define PG8_LAS __attribute__((address_space(3)))
typedef unsigned short bf16_t;
typedef short bf16x8 __attribute__((ext_vector_type(8)));
typedef float f32x4 __attribute__((ext_vector_type(4)));
typedef unsigned u32x4 __attribute__((ext_vector_type(4)));
constexpr int BM = 256, BK = 64, HALF = 128, HTB = HALF * BK * 2  , STAGE_BYTES = 8 * HTB, NXCD = 8, WGM = 8;

__host__ __device__ __forceinline__ int lds_byte(int r, int c) { const int st = (r >> 4) * 2 + (c >> 5), rr = r & 15, cc = c & 31, ob = rr * 64 + cc * 2; return st * 1024 + (ob ^ (((ob >> 9) & 1) << 5)); }
__host__ __device__ __forceinline__ void stage_rc(int b, int& R, int& C) { const int st = b / 1024, sb = b % 1024, swz = sb ^ (((sb >> 9) & 1) << 5); R = (st >> 1) * 16 + swz / 64; C = (st & 1) * 32 + (swz % 64) / 2; }
__host__ __device__ __forceinline__ int perm32(int rho) { const int n = rho >> 4, i = rho & 15; return 8 * (i >> 2) + 4 * n + (i & 3); }

struct Unit { int pm, pn; };
struct Gemm { const bf16_t* A; const bf16_t* Bt; int M, N, K; };

struct StaticOrder {
    int nM, nN, nwg, G, c;
    __host__ __device__ void init(int M, int N, int G_, int c_) { nM = M / BM; nN = N / BM; nwg = nM * nN; G = G_; c = c_; }
    __host__ __device__ bool next(int i, Unit& u) const {
        const long L = (long)i * G + c; if (L >= nwg) return false;
        int wgid = (int)L; { const int q = nwg / NXCD, r = nwg % NXCD, xcd = wgid % NXCD, off = wgid / NXCD; wgid = (xcd < r ? xcd * (q + 1) : r * (q + 1) + (xcd - r) * q) + off; }
        const int nig = WGM * nN, gid = wgid / nig, fm = gid * WGM, gsz = (nM - fm) < WGM ? (nM - fm) : WGM;
        u.pm = fm + ((wgid % nig) % gsz); u.pn = (wgid % nig) / gsz; return true;
    }
    __device__ __forceinline__ void a_ready(const Unit&) const {}
    __device__ __forceinline__ void done(const Unit&) const {}
};
struct CountedOrder : StaticOrder {
    const unsigned* ready; unsigned need; unsigned* tmo;
    __device__ __forceinline__ void a_ready(const Unit& u) const {
        if (threadIdx.x < 64) {
            const unsigned long long t0 = __builtin_amdgcn_s_memrealtime(); unsigned polls = 0;
            while ((unsigned)__builtin_amdgcn_readfirstlane(__hip_atomic_load(ready + 64 * u.pm, __ATOMIC_RELAXED, __HIP_MEMORY_SCOPE_AGENT)) < need) {
                if ((++polls & 255u) == 0u && __builtin_amdgcn_readfirstlane(__hip_atomic_load(tmo, __ATOMIC_RELAXED, __HIP_MEMORY_SCOPE_AGENT)) != 0u) break;
                if (__builtin_amdgcn_s_memrealtime() - t0 > 2000000ull) {
                    if (threadIdx.x == 0) { unsigned expect = 0u; __hip_atomic_compare_exchange_strong(tmo + 1, &expect, 0x600u | (unsigned)(u.pm & 0xff), __ATOMIC_RELAXED, __ATOMIC_RELAXED, __HIP_MEMORY_SCOPE_AGENT); __hip_atomic_store(tmo, 1u, __ATOMIC_RELAXED, __HIP_MEMORY_SCOPE_AGENT); }
                    break; }
                __builtin_amdgcn_s_sleep(2); }
            __builtin_amdgcn_fence(__ATOMIC_ACQUIRE, "agent");
            asm volatile("s_waitcnt vmcnt(0)" ::: "memory");
        }
#if !defined(BROKEN_HOOK_NO_BARRIER)
        asm volatile("" ::: "memory"); __builtin_amdgcn_s_barrier(); asm volatile("" ::: "memory");
#endif
    }
};

__device__ __forceinline__ unsigned cvt_pk_bf16(float lo, float hi) { unsigned r; asm volatile("v_cvt_pk_bf16_f32 %0, %1, %2" : "=v"(r) : "v"(lo), "v"(hi)); return r; }
typedef float f32x2 __attribute__((ext_vector_type(2)));
__device__ __forceinline__ f32x2 gelu_pk(f32x2 v) {
    const f32x2 av = __builtin_elementwise_abs(v), d = av * 0.2316418882f + 1.0f;
    f32x2 t; t.x = __builtin_amdgcn_rcpf(d.x); t.y = __builtin_amdgcn_rcpf(d.y);
    f32x2 q = t * 0.5307027145f + (-0.7265760135f); q = q * t + 0.7107068705f; q = q * t + (-0.142248368f); q = q * t + 0.127414796f; q = q * t;
    const f32x2 s = (v * v) * (-0.72134752044f);
    f32x2 e; e.x = __builtin_amdgcn_exp2f(s.x); e.y = __builtin_amdgcn_exp2f(s.y);
    const f32x2 m = v * (q * e), r = v - m;
    f32x2 o; o.x = v.x < 0.f ? m.x : r.x; o.y = v.y < 0.f ? m.y : r.y; return o;
}

struct EpiF32 {
    static constexpr bool PERM = false, AFTER_DRAIN = false;
    float* C; int ldc; const float* bias;
    __device__ __forceinline__ void operator()(const f32x4 (&acc)[2][2][4][2], const Unit& u, int wr, int wc, int fr, int fq) const {
        const int row0 = u.pm * BM + wr * 64 + fr, col0 = u.pn * BM + wc * 32 + 4 * fq;
        f32x4 bv[2][2];
#pragma unroll
        for (int bj = 0; bj < 2; ++bj)
#pragma unroll
            for (int n = 0; n < 2; ++n) bv[bj][n] = bias ? *(const f32x4*)(bias + col0 + bj * HALF + n * 16) : (f32x4){0.f, 0.f, 0.f, 0.f};
#pragma unroll
        for (int ai = 0; ai < 2; ++ai)
#pragma unroll
            for (int m = 0; m < 4; ++m) { float* rowp = C + (size_t)(row0 + ai * HALF + m * 16) * ldc + col0;
#pragma unroll
                for (int bj = 0; bj < 2; ++bj)
#pragma unroll
                    for (int n = 0; n < 2; ++n) *(f32x4*)(rowp + bj * HALF + n * 16) = acc[ai][bj][m][n] + bv[bj][n]; }
    }
};
template <int ACT  > struct EpiBf16 {
    static constexpr bool PERM = true, AFTER_DRAIN = false;
    bf16_t* O; int ldc; const float* bias; int split_cols; size_t split_stride;
    __device__ __forceinline__ void operator()(const f32x4 (&acc)[2][2][4][2], const Unit& u, int wr, int wc, int fr, int fq) const {
        const int row0 = u.pm * BM + wr * 64 + fr; int colt = u.pn * BM; bf16_t* base = O;
        if (split_cols) { const int t = colt / split_cols; base += (size_t)t * split_stride; colt -= t * split_cols; }
        const int col0 = colt + wc * 32 + 8 * fq, bcol0 = u.pn * BM + wc * 32 + 8 * fq;
        f32x4 bv[2][2];
#pragma unroll
        for (int bj = 0; bj < 2; ++bj)
#pragma unroll
            for (int n = 0; n < 2; ++n) bv[bj][n] = bias ? *(const f32x4*)(bias + bcol0 + bj * HALF + 4 * n) : (f32x4){0.f, 0.f, 0.f, 0.f};
#pragma unroll
        for (int ai = 0; ai < 2; ++ai)
#pragma unroll
            for (int m = 0; m < 4; ++m) { bf16_t* rowp = base + (size_t)(row0 + ai * HALF + m * 16) * ldc + col0;
#pragma unroll
                for (int bj = 0; bj < 2; ++bj) { f32x4 v0 = acc[ai][bj][m][0] + bv[bj][0], v1 = acc[ai][bj][m][1] + bv[bj][1];
                    if (ACT == 1) { f32x2 a = gelu_pk((f32x2){v0[0], v0[1]}), b = gelu_pk((f32x2){v0[2], v0[3]}), c = gelu_pk((f32x2){v1[0], v1[1]}), d = gelu_pk((f32x2){v1[2], v1[3]});
                        v0 = (f32x4){a.x, a.y, b.x, b.y}; v1 = (f32x4){c.x, c.y, d.x, d.y}; }
                    if (ACT == 2) {
#pragma unroll
                        for (int j = 0; j < 4; ++j) { v0[j] = 0.5f * v0[j] * (1.0f + erff(v0[j] * 0.70710678f)); v1[j] = 0.5f * v1[j] * (1.0f + erff(v1[j] * 0.70710678f)); } }
                    u32x4 w; w.x = cvt_pk_bf16(v0[0], v0[1]); w.y = cvt_pk_bf16(v0[2], v0[3]); w.z = cvt_pk_bf16(v1[0], v1[1]); w.w = cvt_pk_bf16(v1[2], v1[3]);
                    *(u32x4*)(rowp + bj * HALF) = w; } }
    }
};

struct PanelStats {
    unsigned* xbuf;
    unsigned* cnt;
    unsigned* tmo;
    int ntn; float eps;
    unsigned code;
    __device__ __forceinline__ bool run(const f32x4 (&v)[2][2][4][2], const Unit& u, int wr, int wc, int fr, int fq, PG8_LAS unsigned char* lds, int wid, int lane) const {
        typedef float f32x2v __attribute__((ext_vector_type(2)));
        PG8_LAS f32x2v* P = (PG8_LAS f32x2v*)lds;
        PG8_LAS f32x2v* S = (PG8_LAS f32x2v*)(lds + 8192);
        PG8_LAS unsigned* flag = (PG8_LAS unsigned*)(lds + 8192 + 2048);
#pragma unroll
        for (int ai = 0; ai < 2; ++ai)
#pragma unroll
            for (int m = 0; m < 4; ++m) {
                float s = 0.f;
#pragma unroll
                for (int bj = 0; bj < 2; ++bj)
#pragma unroll
                    for (int n = 0; n < 2; ++n) { const f32x4 x = v[ai][bj][m][n]; s += (x[0] + x[1]) + (x[2] + x[3]); }
                s += __shfl_xor(s, 16); s += __shfl_xor(s, 32);
                const float mw = s * (1.0f / 64.0f); float q = 0.f;
#pragma unroll
                for (int bj = 0; bj < 2; ++bj)
#pragma unroll
                    for (int n = 0; n < 2; ++n) { const f32x4 d = v[ai][bj][m][n] - mw; q += (d[0] * d[0] + d[1] * d[1]) + (d[2] * d[2] + d[3] * d[3]); }
                q += __shfl_xor(q, 16); q += __shfl_xor(q, 32);
                if (fq == 0) P[(ai * HALF + wr * 64 + m * 16 + fr) * 4 + wc] = (f32x2v){mw, q};
            }
        asm volatile("s_waitcnt lgkmcnt(0)" ::: "memory"); __builtin_amdgcn_s_barrier(); asm volatile("" ::: "memory");
#if defined(BROKEN_NO_WAIT)
        if (blockIdx.x >= 64) { const long long t0 = clock64(); while (clock64() - t0 < 60000) __builtin_amdgcn_s_sleep(8); }
#endif
        const int row = wid * 32 + (lane & 31);
        if (lane < 32) {
            const f32x2v a = P[row * 4 + 0], b = P[row * 4 + 1], c = P[row * 4 + 2], d = P[row * 4 + 3];
            const float mt = (a.x + b.x + c.x + d.x) * 0.25f;
            const float da = a.x - mt, db = b.x - mt, dc = c.x - mt, dd = d.x - mt;
            const float m2 = (a.y + b.y) + (c.y + d.y) + 64.0f * ((da * da + db * db) + (dc * dc + dd * dd));
            unsigned long long* slot = (unsigned long long*)xbuf + ((size_t)(u.pm * BM + row) * 4 + u.pn);
            __hip_atomic_store(slot, ((unsigned long long)__float_as_uint(m2) << 32) | __float_as_uint(mt), __ATOMIC_RELAXED, __HIP_MEMORY_SCOPE_AGENT);
        }
        asm volatile("s_waitcnt vmcnt(0)" ::: "memory");
        if (lane == 0) __hip_atomic_fetch_add(cnt + 64 * u.pm, 1u, __ATOMIC_RELAXED, __HIP_MEMORY_SCOPE_AGENT);
        if (wid == 0) {
            bool dead = false; const unsigned long long t0 = __builtin_amdgcn_s_memrealtime(); const unsigned want = 8u * (unsigned)ntn;
            for (;;) {
#if defined(BROKEN_NO_WAIT)
                break;
#endif
                if ((unsigned)__builtin_amdgcn_readfirstlane(__hip_atomic_load(cnt + 64 * u.pm, __ATOMIC_RELAXED, __HIP_MEMORY_SCOPE_AGENT)) >= want) break;
                if (__builtin_amdgcn_s_memrealtime() - t0 > 2000000ull) {
                    if (lane == 0) { unsigned expect = 0u; __hip_atomic_compare_exchange_strong(tmo + 1, &expect, code | (unsigned)(u.pm & 0xff), __ATOMIC_RELAXED, __ATOMIC_RELAXED, __HIP_MEMORY_SCOPE_AGENT);
                                     __hip_atomic_store(tmo, 1u, __ATOMIC_RELAXED, __HIP_MEMORY_SCOPE_AGENT); }
                    dead = true; break; }
                __builtin_amdgcn_s_sleep(2);
            }
            __builtin_amdgcn_fence(__ATOMIC_ACQUIRE, "agent");
            if (lane == 0) flag[0] = dead ? 1u : 0u;
        }
        asm volatile("s_waitcnt vmcnt(0) lgkmcnt(0)" ::: "memory"); __builtin_amdgcn_s_barrier(); asm volatile("" ::: "memory");
        const bool bad = flag[0] != 0u;
        if (lane < 32) {
            const unsigned long long* slot = (const unsigned long long*)xbuf + (size_t)(u.pm * BM + row) * 4; float mt[4], m2[4]; float ms = 0.f;
#pragma unroll
            for (int t = 0; t < 4; ++t) { if (t < ntn) { const unsigned long long w = __hip_atomic_load(slot + t, __ATOMIC_RELAXED, __HIP_MEMORY_SCOPE_AGENT); mt[t] = __uint_as_float((unsigned)w); m2[t] = __uint_as_float((unsigned)(w >> 32)); } else { mt[t] = 0.f; m2[t] = 0.f; } ms += mt[t]; }
            const float mean = ms / (float)ntn; float q = 0.f;
#pragma unroll
            for (int t = 0; t < 4; ++t) if (t < ntn) { const float dm = mt[t] - mean; q += m2[t] + 256.0f * dm * dm; }
            S[row] = (f32x2v){mean, 1.0f / sqrtf(q / (256.0f * (float)ntn) + eps)};
        }
        asm volatile("s_waitcnt lgkmcnt(0)" ::: "memory"); __builtin_amdgcn_s_barrier(); asm volatile("" ::: "memory");
        return bad;
    }
};
struct EpiLnRes {
    static constexpr bool PERM = false, AFTER_DRAIN = true;
    const float* base; float* out; int ldc; const float* bias; PanelStats st; unsigned poison;
    __device__ __forceinline__ void refuse(size_t i0, size_t stride, int M, int N) const { const float q = __builtin_nanf(""); for (size_t i = i0; i < (size_t)M * N; i += stride) out[(i / N) * ldc + i % N] = q;
        if (i0 == 0) { unsigned expect = 0u; __hip_atomic_compare_exchange_strong(st.tmo + 1, &expect, 0x7f0u, __ATOMIC_RELAXED, __ATOMIC_RELAXED, __HIP_MEMORY_SCOPE_AGENT); __hip_atomic_store(st.tmo, 1u, __ATOMIC_RELAXED, __HIP_MEMORY_SCOPE_AGENT); } }
    __device__ __forceinline__ void fused(f32x4 (&acc)[2][2][4][2], const Unit& u, int wr, int wc, int fr, int fq, PG8_LAS unsigned char* lds, int wid, int lane) const {
        typedef float f32x2v __attribute__((ext_vector_type(2)));
        const PG8_LAS f32x2v* S = (const PG8_LAS f32x2v*)(lds + 8192);
        const int col0 = u.pn * BM + wc * 32 + 4 * fq;
#pragma unroll
        for (int bj = 0; bj < 2; ++bj)
#pragma unroll
            for (int n = 0; n < 2; ++n) { const f32x4 bv = bias ? *(const f32x4*)(bias + col0 + bj * HALF + n * 16) : (f32x4){0.f, 0.f, 0.f, 0.f};
#pragma unroll
                for (int ai = 0; ai < 2; ++ai)
#pragma unroll
                    for (int m = 0; m < 4; ++m) acc[ai][bj][m][n] += bv; }
        const bool bad = st.run(acc, u, wr, wc, fr, fq, lds, wid, lane) || poison != 0u;
        const float qnan = __builtin_nanf("");
#pragma unroll
        for (int ai = 0; ai < 2; ++ai)
#pragma unroll
            for (int m = 0; m < 4; ++m) { const int r = ai * HALF + wr * 64 + m * 16 + fr; const f32x2v sr = S[r]; const size_t off = (size_t)(u.pm * BM + r) * ldc + col0;
#pragma unroll
                for (int bj = 0; bj < 2; ++bj)
#pragma unroll
                    for (int n = 0; n < 2; ++n) { const f32x4 bs = *(const f32x4*)(base + off + bj * HALF + n * 16); f32x4 o = bs + (acc[ai][bj][m][n] - sr.x) * sr.y;
                        if (bad) o = (f32x4){qnan, qnan, qnan, qnan}; *(f32x4*)(out + off + bj * HALF + n * 16) = o; }
                asm volatile("" ::: "memory"); }
    }
};
struct EpiLnResLn {
    static constexpr bool PERM = false, AFTER_DRAIN = true;
    const float* base; float* out; bf16_t* xn; int ldc; const float* bias; PanelStats st1, st2; unsigned poison;
    __device__ __forceinline__ void refuse(size_t i0, size_t stride, int M, int N) const { const float q = __builtin_nanf(""); for (size_t i = i0; i < (size_t)M * N; i += stride) { const size_t o = (i / N) * ldc + i % N; out[o] = q; xn[o] = (bf16_t)0x7fc0u; }
        if (i0 == 0) { unsigned expect = 0u; __hip_atomic_compare_exchange_strong(st1.tmo + 1, &expect, 0x7f0u, __ATOMIC_RELAXED, __ATOMIC_RELAXED, __HIP_MEMORY_SCOPE_AGENT); __hip_atomic_store(st1.tmo, 1u, __ATOMIC_RELAXED, __HIP_MEMORY_SCOPE_AGENT); } }
    __device__ __forceinline__ void fused(f32x4 (&acc)[2][2][4][2], const Unit& u, int wr, int wc, int fr, int fq, PG8_LAS unsigned char* lds, int wid, int lane) const {
        typedef float f32x2v __attribute__((ext_vector_type(2))); typedef unsigned u32x2v __attribute__((ext_vector_type(2)));
        const PG8_LAS f32x2v* S = (const PG8_LAS f32x2v*)(lds + 8192);
        const int col0 = u.pn * BM + wc * 32 + 4 * fq;
#pragma unroll
        for (int bj = 0; bj < 2; ++bj)
#pragma unroll
            for (int n = 0; n < 2; ++n) { const f32x4 bv = bias ? *(const f32x4*)(bias + col0 + bj * HALF + n * 16) : (f32x4){0.f, 0.f, 0.f, 0.f};
#pragma unroll
                for (int ai = 0; ai < 2; ++ai)
#pragma unroll
                    for (int m = 0; m < 4; ++m) acc[ai][bj][m][n] += bv; }
        bool bad = st1.run(acc, u, wr, wc, fr, fq, lds, wid, lane) || poison != 0u;
        const float qnan = __builtin_nanf("");
#pragma unroll
        for (int ai = 0; ai < 2; ++ai)
#pragma unroll
            for (int m = 0; m < 4; ++m) { const int r = ai * HALF + wr * 64 + m * 16 + fr; const f32x2v sr = S[r]; const size_t off = (size_t)(u.pm * BM + r) * ldc + col0;
#pragma unroll
                for (int bj = 0; bj < 2; ++bj)
#pragma unroll
                    for (int n = 0; n < 2; ++n) { const f32x4 bs = *(const f32x4*)(base + off + bj * HALF + n * 16); acc[ai][bj][m][n] = bs + (acc[ai][bj][m][n] - sr.x) * sr.y; }
                asm volatile("" : "+v"(acc[ai][0][m][0]), "+v"(acc[ai][0][m][1]), "+v"(acc[ai][1][m][0]), "+v"(acc[ai][1][m][1]));
                if (m & 1) asm volatile("" ::: "memory"); }
        const bool bad1 = bad;
        bad = st2.run(acc, u, wr, wc, fr, fq, lds, wid, lane) || bad;
#pragma unroll
        for (int ai = 0; ai < 2; ++ai)
#pragma unroll
            for (int m = 0; m < 4; ++m) { const int r = ai * HALF + wr * 64 + m * 16 + fr; const f32x2v sr = S[r]; const size_t off = (size_t)(u.pm * BM + r) * ldc + col0;
#pragma unroll
                for (int bj = 0; bj < 2; ++bj)
#pragma unroll
                    for (int n = 0; n < 2; ++n) { const f32x4 x1 = acc[ai][bj][m][n]; *(f32x4*)(out + off + bj * HALF + n * 16) = bad1 ? (f32x4){qnan, qnan, qnan, qnan} : x1;
                        const f32x4 o = (x1 - sr.x) * sr.y; u32x2v w; w.x = cvt_pk_bf16(o[0], o[1]); w.y = cvt_pk_bf16(o[2], o[3]);
                        if (bad) { w.x = 0x7fc07fc0u; w.y = 0x7fc07fc0u; } *(u32x2v*)(xn + off + bj * HALF + n * 16) = w; }
                asm volatile("" ::: "memory"); }
    }
};

template <class Epi, class Sched, bool STAMP = false>
__device__ __forceinline__ void gemm_phase(PG8_LAS unsigned char* lds, const Gemm g, const Sched& S, const Epi& E, unsigned long long* stamps) {
    int tid_o = threadIdx.x; asm volatile("" : "+v"(tid_o)); const int tid = tid_o, wid = __builtin_amdgcn_readfirstlane(tid >> 6), lane = tid & 63, wr = wid >> 2, wc = wid & 3, fr = lane & 15, fq = lane >> 4;
    const int K = g.K, nt = K / BK;
    int ts_lo = 0, ts_hi = 0, nts = 0; const unsigned long long rt_entry = STAMP ? (unsigned long long)wall_clock64() : 0ull;
#define PG8_STAMP() do { if (STAMP && wid == 0 && nts < 64) { const unsigned long long _c = (unsigned long long)clock64(); \
        ts_lo = (lane == nts) ? (int)(unsigned)_c : ts_lo; ts_hi = (lane == nts) ? (int)(unsigned)(_c >> 32) : ts_hi; ++nts; } } while (0)
    PG8_STAMP();
    unsigned voffA[2], voffB[2];
#pragma unroll
    for (int i = 0; i < 2; ++i) { int R, C; stage_rc(tid * 16 + i * 8192, R, C); const int Rb = Epi::PERM ? ((R & ~31) + perm32(R & 31)) : R;
        voffA[i] = (unsigned)(R * K + C) * 2u; voffB[i] = (unsigned)(Rb * K + C) * 2u; }
    const size_t kstep = (size_t)(BK * 2);
    const size_t hstep = (size_t)HALF * K * 2;
    const size_t tstep = 2 * hstep;
    const unsigned ldsw = (unsigned)wid * 1024u;
    const int aoff = lds_byte(wr * 64 + fr, fq * 8), boff = lds_byte(wc * 32 + fr, fq * 8);
#define PG8_SA(b, h) (((b) * 2 + (h)) * HTB)
#define PG8_SB(b, h) ((4 + (b) * 2 + (h)) * HTB)
#define PG8_STAGE(bufoff, gbase, voff) do { _Pragma("unroll") for (int _i = 0; _i < 2; ++_i) \
        __builtin_amdgcn_global_load_lds((const unsigned*)((const char*)(gbase) + (voff)[_i]), (PG8_LAS unsigned*)(lds + (bufoff) + ldsw + _i * 8192), 16, 0, 0); } while (0)
#define PG8_LDA(dst, b, h) do { _Pragma("unroll") for (int m = 0; m < 4; ++m) _Pragma("unroll") for (int k = 0; k < 2; ++k) dst[m][k] = *(const PG8_LAS bf16x8*)(lds + PG8_SA(b, h) + aoff + m * 2048 + k * 1024); } while (0)
#define PG8_LDB(dst, b, h) do { _Pragma("unroll") for (int n = 0; n < 2; ++n) _Pragma("unroll") for (int k = 0; k < 2; ++k) dst[n][k] = *(const PG8_LAS bf16x8*)(lds + PG8_SB(b, h) + boff + n * 2048 + k * 1024); } while (0)
#define PG8_MMA(ai, bj, At, Bt) do { __builtin_amdgcn_s_setprio(1); _Pragma("unroll") for (int m = 0; m < 4; ++m) _Pragma("unroll") for (int n = 0; n < 2; ++n) _Pragma("unroll") for (int k = 0; k < 2; ++k) \
        acc[ai][bj][m][n] = __builtin_amdgcn_mfma_f32_16x16x32_bf16(Bt[n][k], At[m][k], acc[ai][bj][m][n], 0, 0, 0); __builtin_amdgcn_s_setprio(0); } while (0)
#define PG8_WAIT_V(n) asm volatile("s_waitcnt vmcnt(" #n ")" ::: "memory")
#define PG8_WAIT_L(n) asm volatile("s_waitcnt lgkmcnt(" #n ")" ::: "memory")
#define PG8_BAR __builtin_amdgcn_s_barrier()
#define PG8_SCHED __builtin_amdgcn_sched_barrier(0)
    Unit cur, nxt; int ui = 0;
    if (!S.next(0, cur)) return;
    f32x4 acc[2][2][4][2];
#pragma unroll
    for (int a = 0; a < 2; ++a)
#pragma unroll
        for (int b = 0; b < 2; ++b)
#pragma unroll
            for (int m = 0; m < 4; ++m)
#pragma unroll
                for (int n = 0; n < 2; ++n) acc[a][b][m][n] = (f32x4){0.f, 0.f, 0.f, 0.f};
    bf16x8 At[4][2], B0[2][2], B1[2][2];
    const char* cA = (const char*)g.A + (size_t)cur.pm * tstep; const char* cB = (const char*)g.Bt + (size_t)cur.pn * tstep;
    S.a_ready(cur);
    PG8_STAGE(PG8_SB(0, 0), cB, voffB); PG8_STAGE(PG8_SA(0, 0), cA, voffA); PG8_STAGE(PG8_SB(0, 1), cB + hstep, voffB); PG8_STAGE(PG8_SA(0, 1), cA + hstep, voffA);
    if (wr == 1) PG8_BAR;
    PG8_WAIT_V(4); PG8_BAR;
    PG8_STAGE(PG8_SB(1, 0), cB + kstep, voffB); PG8_STAGE(PG8_SA(1, 0), cA + kstep, voffA); PG8_STAGE(PG8_SB(1, 1), cB + hstep + kstep, voffB);
    PG8_WAIT_V(6); PG8_BAR;
    PG8_STAMP();
    for (;;) {
        const bool has_next = S.next(ui + 1, nxt);
        const char* nA = has_next ? (const char*)g.A + (size_t)nxt.pm * tstep : cA; const char* nB = has_next ? (const char*)g.Bt + (size_t)nxt.pn * tstep : cB;
        for (int t = 0; t < nt; t += 2) {
            const bool last = (t == nt - 2);
            const char* a1 = cA + (size_t)(t + 1) * kstep;
            const char* a2 = last ? nA : cA + (size_t)(t + 2) * kstep; const char* b2 = last ? nB : cB + (size_t)(t + 2) * kstep;
            const char* a3 = a2 + kstep; const char* b3 = b2 + kstep;
            if (last && has_next) S.a_ready(nxt);
            PG8_LDB(B0, 0, 0); PG8_SCHED; PG8_LDA(At, 0, 0); PG8_STAGE(PG8_SA(1, 1), a1 + hstep, voffA);
            PG8_WAIT_L(8); PG8_BAR; PG8_WAIT_L(0); PG8_MMA(0, 0, At, B0); PG8_BAR; PG8_SCHED;
            PG8_LDB(B1, 0, 1); PG8_STAGE(PG8_SB(0, 0), b2, voffB);
            PG8_BAR; PG8_WAIT_L(0); PG8_MMA(0, 1, At, B1); PG8_BAR;
            PG8_LDA(At, 0, 1); PG8_STAGE(PG8_SA(0, 0), a2, voffA);
            PG8_BAR; PG8_WAIT_L(0); PG8_MMA(1, 0, At, B0); PG8_BAR; PG8_SCHED;
            PG8_STAGE(PG8_SB(0, 1), b2 + hstep, voffB);
            PG8_WAIT_V(6); PG8_BAR; PG8_MMA(1, 1, At, B1); PG8_BAR;
            PG8_LDB(B0, 1, 0); PG8_SCHED; PG8_LDA(At, 1, 0); PG8_STAGE(PG8_SA(0, 1), a2 + hstep, voffA);
            PG8_WAIT_L(8); PG8_BAR; PG8_WAIT_L(0); PG8_MMA(0, 0, At, B0); PG8_BAR; PG8_SCHED;
            PG8_LDB(B1, 1, 1); PG8_STAGE(PG8_SB(1, 0), b3, voffB);
            PG8_BAR; PG8_WAIT_L(0); PG8_MMA(0, 1, At, B1); PG8_BAR;
            PG8_LDA(At, 1, 1); PG8_STAGE(PG8_SA(1, 0), a3, voffA);
            PG8_BAR; PG8_WAIT_L(0); PG8_MMA(1, 0, At, B0); PG8_BAR; PG8_SCHED;
            PG8_STAGE(PG8_SB(1, 1), b3 + hstep, voffB);
            PG8_WAIT_V(6); PG8_BAR; PG8_MMA(1, 1, At, B1); PG8_BAR;
        }
        PG8_STAMP();
        if constexpr (!Epi::AFTER_DRAIN) { E(acc, cur, wr, wc, fr, fq); S.done(cur); }
        PG8_STAMP();
        if (!has_next) break;
#pragma unroll
        for (int a = 0; a < 2; ++a)
#pragma unroll
            for (int b = 0; b < 2; ++b)
#pragma unroll
                for (int m = 0; m < 4; ++m)
#pragma unroll
                    for (int n = 0; n < 2; ++n) acc[a][b][m][n] = (f32x4){0.f, 0.f, 0.f, 0.f};
        cur = nxt; cA = nA; cB = nB; ++ui;
    }
    PG8_WAIT_V(0);
    if (wr == 0) PG8_BAR;
    PG8_BAR;
    if constexpr (Epi::AFTER_DRAIN) { E.fused(acc, cur, wr, wc, fr, fq, lds, wid, lane); S.done(cur); }
    PG8_STAMP();
    if (STAMP && wid == 0) { stamps[lane] = lane < nts ? (((unsigned long long)(unsigned)ts_hi << 32) | (unsigned)ts_lo) : 0ull;
        if (lane == 62) stamps[62] = rt_entry; if (lane == 63) stamps[63] = (unsigned long long)wall_clock64(); }
#undef PG8_STAMP
#undef PG8_SA
#undef PG8_SB
#undef PG8_STAGE
#undef PG8_LDA
#undef PG8_LDB
#undef PG8_MMA
#undef PG8_WAIT_V
#undef PG8_WAIT_L
#undef PG8_BAR
#undef PG8_SCHED
}
}

#include <hip/hip_cooperative_groups.h>
#include <cstdio>
namespace cg = cooperative_groups;
#define LAS __attribute__((address_space(3)))
using pg8::bf16_t; using pg8::bf16x8; using pg8::f32x4; using pg8::u32x4; using pg8::cvt_pk_bf16;
typedef float f32x2 __attribute__((ext_vector_type(2)));
typedef unsigned u32x2 __attribute__((ext_vector_type(2)));

constexpr int NB = 8, TT = 4112, SEQL = 4096, NMETA = 16, DM = 1024, DFF = 2816, DEPTH = 4;
constexpr int MTOK = NB * TT;
constexpr int MP = 33024;
constexpr int MMAIN = NB * SEQL;
constexpr int MROWS = MMAIN + NMETA;
__device__ __forceinline__ int rowi(int b, int t) { return t < NMETA ? MMAIN + t : b * SEQL + t - NMETA; }
constexpr int LDP = 2816;
constexpr int DIN = 2832, NINP = 3072;
constexpr float ALPHA = 1.681792830507429f;
constexpr int NTHR = 512;
constexpr int LDS_BYTES = pg8::STAGE_BYTES;

constexpr size_t SZ_WGU = (size_t)5632 * 1024 * 2, SZ_WD = (size_t)1024 * 2816 * 2, SZ_WIN = (size_t)NINP * 1024 * 2, SZ_WOUT = (size_t)1024 * 1024 * 2;
constexpr size_t WO_GU0 = 0, WO_D0 = WO_GU0 + SZ_WGU, WO_GU1 = WO_D0 + SZ_WD, WO_D1 = WO_GU1 + SZ_WGU, WO_IN = WO_D1 + SZ_WD, WO_OUT = WO_IN + SZ_WIN, SZ_WSET = WO_OUT + SZ_WOUT;
constexpr size_t WS_WB = 0;
constexpr size_t WS_H = WS_WB + 2 * SZ_WSET;
constexpr size_t WS_HB = WS_H + (size_t)MP * DM * 4;
constexpr size_t WS_U = WS_HB + (size_t)MP * DM * 2;
constexpr size_t WS_SMALL = WS_U + (size_t)MP * LDP * 2;
constexpr size_t WS_END = WS_SMALL + (size_t)MP * 16 * 4;
constexpr size_t DO_MIXB = 0, DO_ODN = (size_t)MP * DM * 2;

struct Params { const float* in[26]; float* out; unsigned char* ws; };

__device__ __forceinline__ float bf_lo(unsigned u) { return __uint_as_float(u << 16); }
__device__ __forceinline__ float bf_hi(unsigned u) { return __uint_as_float(u & 0xffff0000u); }
__device__ __forceinline__ float sigmoidf_(float x) { return 1.f / (1.f + __expf(-x)); }
__device__ __forceinline__ float siluf_(float x) { return x / (1.f + __expf(-x)); }
__device__ __forceinline__ float softplusf_(float x) { return fmaxf(x, 0.f) + log1pf(expf(-fabsf(x))); }
__device__ __forceinline__ float gelu_tanhf_(float x) { const float z = 0.7978845608028654f * (x + 0.044715f * x * x * x); const float t = 1.f - 2.f / (1.f + __expf(2.f * z)); return 0.5f * x * (1.f + t); }
__device__ __forceinline__ int otid() { int t = threadIdx.x; asm volatile("" : "+v"(t)); return t; }
template <int CTRL> __device__ __forceinline__ float dpp_f(float x) { return __int_as_float(__builtin_amdgcn_update_dpp(0, __float_as_int(x), CTRL, 0xf, 0xf, false)); }
__device__ __forceinline__ float allreduce8(float x) { x += dpp_f<0xB1>(x); x += dpp_f<0x4E>(x); x += dpp_f<0x141>(x); return x; }
__device__ __forceinline__ float allreduce16(float x) { x = allreduce8(x); x += dpp_f<0x140>(x); return x; }

__device__ __forceinline__ float rl_(float x, int l) { return __int_as_float(__builtin_amdgcn_readlane(__float_as_int(x), l)); }
__device__ __forceinline__ float allreduce64(float x) { x = allreduce16(x); return (rl_(x, 0) + rl_(x, 16)) + (rl_(x, 32) + rl_(x, 48)); }
struct EpiSwiGLU {
    static constexpr bool PERM = false, AFTER_DRAIN = false;
    bf16_t* O;
    __device__ __forceinline__ void operator()(const f32x4 (&acc)[2][2][4][2], const pg8::Unit& u, int wr, int wc, int fr, int fq) const {
        const int row0 = u.pm * 256 + wr * 64 + fr, col = u.pn * 128 + wc * 32 + fq * 8;
#pragma unroll
        for (int ai = 0; ai < 2; ++ai)
#pragma unroll
            for (int m = 0; m < 4; ++m) {
                const f32x4 g0 = acc[ai][0][m][0], u0 = acc[ai][0][m][1], g1 = acc[ai][1][m][0], u1 = acc[ai][1][m][1];
                float v[8];
#pragma unroll
                for (int j = 0; j < 4; ++j) { v[j] = siluf_(g0[j]) * u0[j]; v[4 + j] = siluf_(g1[j]) * u1[j]; }
                u32x4 w; w.x = cvt_pk_bf16(v[0], v[1]); w.y = cvt_pk_bf16(v[2], v[3]); w.z = cvt_pk_bf16(v[4], v[5]); w.w = cvt_pk_bf16(v[6], v[7]);
                *(u32x4*)(O + (size_t)(row0 + ai * 128 + m * 16) * DFF + col) = w;
            }
    }
};
struct EpiResid {
    static constexpr bool PERM = false, AFTER_DRAIN = false;
    float* Hh; float scale;
    __device__ __forceinline__ void operator()(const f32x4 (&acc)[2][2][4][2], const pg8::Unit& u, int wr, int wc, int fr, int fq) const {
        const int row0 = u.pm * 256 + wr * 64 + fr, col0 = u.pn * 256 + wc * 32 + 4 * fq;
#pragma unroll
        for (int ai = 0; ai < 2; ++ai)
#pragma unroll
            for (int m = 0; m < 4; ++m) { float* rowp = Hh + (size_t)(row0 + ai * 128 + m * 16) * DM + col0;
#pragma unroll
                for (int bj = 0; bj < 2; ++bj)
#pragma unroll
                    for (int n = 0; n < 2; ++n) { float* p = rowp + bj * 128 + n * 16; const f32x4 h = *(const f32x4*)p; *(f32x4*)p = h * ALPHA + acc[ai][bj][m][n] * scale; } }
    }
};
struct EpiProj {
    static constexpr bool PERM = true, AFTER_DRAIN = false;
    bf16_t* P; float* Sm;
    __device__ __forceinline__ void operator()(const f32x4 (&acc)[2][2][4][2], const pg8::Unit& u, int wr, int wc, int fr, int fq) const {
        const int row0 = u.pm * 256 + wr * 64 + fr;
#pragma unroll
        for (int ai = 0; ai < 2; ++ai)
#pragma unroll
            for (int m = 0; m < 4; ++m) { const size_t row = (size_t)(row0 + ai * 128 + m * 16);
#pragma unroll
                for (int bj = 0; bj < 2; ++bj) { const int c0 = u.pn * 256 + bj * 128 + wc * 32 + 8 * fq; const f32x4 v0 = acc[ai][bj][m][0], v1 = acc[ai][bj][m][1];
                    if (c0 < LDP) { u32x4 w; w.x = cvt_pk_bf16(v0[0], v0[1]); w.y = cvt_pk_bf16(v0[2], v0[3]); w.z = cvt_pk_bf16(v1[0], v1[1]); w.w = cvt_pk_bf16(v1[2], v1[3]); *(u32x4*)(P + row * LDP + c0) = w; }
                    else if (c0 < DIN) { float* sp = Sm + row * 16 + (c0 - LDP); *(f32x4*)sp = v0; *(f32x4*)(sp + 4) = v1; } } }
    }
};

struct TailSwiGLU { bf16_t* O;
    __device__ __forceinline__ void operator()(int q, int fr, int fq, const f32x4& s0, const f32x4& s1) const {
        const int ff = 128 * (q >> 3) + 32 * (q & 3) + 8 * (fr >> 2) + 4 * ((q >> 2) & 1) + (fr & 3);
#pragma unroll
        for (int jj = 0; jj < 4; ++jj) O[(size_t)(MMAIN + 4 * fq + jj) * DFF + ff] = (bf16_t)(cvt_pk_bf16(siluf_(s0[jj]) * s1[jj], 0.f) & 0xffffu); } };
struct TailResid { float* Hh; float scale;
    __device__ __forceinline__ void operator()(int q, int fr, int fq, const f32x4& s0, const f32x4& s1) const {
#pragma unroll
        for (int jj = 0; jj < 4; ++jj) { float* p0 = Hh + (size_t)(MMAIN + 4 * fq + jj) * DM + 32 * q + fr; p0[0] = p0[0] * ALPHA + s0[jj] * scale; p0[16] = p0[16] * ALPHA + s1[jj] * scale; } } };
struct TailProj { bf16_t* P; float* Sm;
    __device__ __forceinline__ void operator()(int q, int fr, int fq, const f32x4& s0, const f32x4& s1) const {
#pragma unroll
        for (int n = 0; n < 2; ++n) { const int col = 32 * q + 16 * n + fr;
#pragma unroll
            for (int jj = 0; jj < 4; ++jj) { const size_t row = (size_t)(MMAIN + 4 * fq + jj); const float v = n ? s1[jj] : s0[jj];
                if (col < LDP) P[row * LDP + col] = (bf16_t)(cvt_pk_bf16(v, 0.f) & 0xffffu); else if (col < DIN) Sm[row * 16 + (col - LDP)] = v; } } } };
template <class EpiT>
__device__ __forceinline__ void skinny_gemm(LAS unsigned char* lds, const bf16_t* A, int lda, const bf16_t* Bt, int K, int ngroups, const EpiT& E) {
    const int tid = otid(), lane = tid & 63, wave = tid >> 6, fr = lane & 15, fq = lane >> 4;
    LAS f32x4* part = (LAS f32x4*)lds;
    const int kw = K >> 3;
    const bf16_t* arow = A + (size_t)(MMAIN + fr) * lda + wave * kw + 8 * fq;
    for (int q = blockIdx.x; q < ngroups; q += gridDim.x) {
        const bf16_t* b0 = Bt + (size_t)(32 * q + fr) * K + wave * kw + 8 * fq;
        const bf16_t* b1 = b0 + (size_t)16 * K;
        f32x4 acc0 = {0.f, 0.f, 0.f, 0.f}, acc1 = {0.f, 0.f, 0.f, 0.f};
#pragma unroll 4
        for (int k = 0; k < kw; k += 32) {
            const bf16x8 a = *(const bf16x8*)(arow + k), x0 = *(const bf16x8*)(b0 + k), x1 = *(const bf16x8*)(b1 + k);
            acc0 = __builtin_amdgcn_mfma_f32_16x16x32_bf16(a, x0, acc0, 0, 0, 0); acc1 = __builtin_amdgcn_mfma_f32_16x16x32_bf16(a, x1, acc1, 0, 0, 0);
        }
        part[(wave * 2 + 0) * 64 + lane] = acc0; part[(wave * 2 + 1) * 64 + lane] = acc1;
        __syncthreads();
        if (wave == 0) { f32x4 s0 = part[lane], s1 = part[64 + lane];
#pragma unroll
            for (int w = 1; w < 8; ++w) { s0 += part[(w * 2) * 64 + lane]; s1 += part[(w * 2 + 1) * 64 + lane]; }
            E(q, fr, fq, s0, s1); }
        __syncthreads();
    }
}

__device__ __forceinline__ int map_row(int mode, int n) {
    if (mode == 0) return n;
    if (mode == 1 || mode == 2) { const int pn = n >> 7, fl = n & 127; return 256 * pn + 128 * ((fl >> 2) & 1) + 32 * (fl >> 5) + 16 * (mode - 1) + 4 * ((fl >> 3) & 3) + (fl & 3); }
    if (n < 1792) return n;
    if (n < 1800) return 2816 + (n - 1792);
    if (n < 2568) return 1792 + (n - 1800);
    if (n < 2824) return 2560 + (n - 2568);
    return 2824 + (n - 2824);
}
__device__ __forceinline__ void convert_tile(LAS float* tl, const float* __restrict__ src, int K, int N, int kt, int nt, bf16_t* dst, int mode) {
    const int tid = otid();
    { const int n = nt * 64 + (tid & 63);
#pragma unroll
      for (int i = 0; i < 8; ++i) { const int kl = i * 8 + (tid >> 6); const float v = (n < N) ? src[(size_t)(kt * 64 + kl) * N + n] : 0.f; tl[(tid & 63) * 65 + kl] = v; } }
    __syncthreads();
    { const int nl = tid >> 3, k8 = (tid & 7) * 8, n = nt * 64 + nl;
      if (n < N) { const int dr = map_row(mode, n); float v[8];
#pragma unroll
        for (int e = 0; e < 8; ++e) v[e] = tl[nl * 65 + k8 + e];
        u32x4 w; w.x = cvt_pk_bf16(v[0], v[1]); w.y = cvt_pk_bf16(v[2], v[3]); w.z = cvt_pk_bf16(v[4], v[5]); w.w = cvt_pk_bf16(v[6], v[7]);
        *(u32x4*)(dst + (size_t)dr * K + kt * 64 + k8) = w; } }
    __syncthreads();
}
__device__ void convert_layer(const Params& p, LAS unsigned char* lds, int l, unsigned char* wset) {
    LAS float* tl = (LAS float*)lds;
    for (int tile = blockIdx.x; tile < 5200; tile += gridDim.x) {
        int id = tile;
        if (id < 4224) { const int mat = id / 704, r = id % 704; const int f = mat / 3, kind = mat % 3;
            if (kind < 2) { const float* src = p.in[4 + kind] + (size_t)(l * 2 + f) * DM * DFF; convert_tile(tl, src, DM, DFF, r / 44, r % 44, (bf16_t*)(wset + (f ? WO_GU1 : WO_GU0)), 1 + kind); }
            else { const float* src = p.in[6] + (size_t)(l * 2 + f) * DFF * DM; convert_tile(tl, src, DFF, DM, r / 16, r % 16, (bf16_t*)(wset + (f ? WO_D1 : WO_D0)), 0); } }
        else if (id < 4224 + 720) { id -= 4224; convert_tile(tl, p.in[7] + (size_t)l * DM * DIN, DM, DIN, id / 45, id % 45, (bf16_t*)(wset + WO_IN), 3); }
        else { id -= 4944; convert_tile(tl, p.in[25] + (size_t)l * DM * DM, DM, DM, id / 16, id % 16, (bf16_t*)(wset + WO_OUT), 0); }
    }
}

__device__ void build_h(const Params& p, float* H, bf16_t* HB) {
    const int tid = otid(); const int lane = tid & 63, wave = tid >> 6;
    for (int r = blockIdx.x * 8 + wave; r < MROWS; r += gridDim.x * 8) {
        const float* src = (r >= MMAIN) ? p.in[1] + (size_t)(r - MMAIN) * DM : p.in[0] + (size_t)r * DM;
#pragma unroll
        for (int i = 0; i < 4; ++i) { const int c = lane * 4 + 256 * i; f32x4 v = {0.f, 0.f, 0.f, 0.f}; if (src) v = *(const f32x4*)(src + c);
            *(f32x4*)(H + (size_t)r * DM + c) = v; u32x2 w; w.x = cvt_pk_bf16(v[0], v[1]); w.y = cvt_pk_bf16(v[2], v[3]); *(u32x2*)(HB + (size_t)r * DM + c) = w; }
    }
}
__device__ void ln_phase(float* H, bf16_t* HB, const float* __restrict__ g, const float* __restrict__ bb, float* outp) {
    const int tid = otid(); const int lane = tid & 63, wave = tid >> 6;
    f32x4 gv[4], bv[4];
#pragma unroll
    for (int i = 0; i < 4; ++i) { gv[i] = *(const f32x4*)(g + lane * 4 + 256 * i); bv[i] = *(const f32x4*)(bb + lane * 4 + 256 * i); }
    for (int r = blockIdx.x * 8 + wave; r < MROWS; r += gridDim.x * 8) {
        f32x4 x[4]; float s = 0.f;
#pragma unroll
        for (int i = 0; i < 4; ++i) { x[i] = *(const f32x4*)(H + (size_t)r * DM + lane * 4 + 256 * i); s += (x[i][0] + x[i][1]) + (x[i][2] + x[i][3]); }
        s = allreduce64(s);
        const float mu = s * (1.f / DM); float q = 0.f;
#pragma unroll
        for (int i = 0; i < 4; ++i) { x[i] = x[i] - mu; q += (x[i][0] * x[i][0] + x[i][1] * x[i][1]) + (x[i][2] * x[i][2] + x[i][3] * x[i][3]); }
        q = allreduce64(q);
        const float rstd = rsqrtf(q * (1.f / DM) + 1e-5f);
#pragma unroll
        for (int i = 0; i < 4; ++i) { const int c = lane * 4 + 256 * i; const f32x4 y = x[i] * rstd * gv[i] + bv[i];
            if (outp) { if (r < MMAIN) *(f32x4*)(outp + (size_t)r * DM + c) = y; }
            else { *(f32x4*)(H + (size_t)r * DM + c) = y; u32x2 w; w.x = cvt_pk_bf16(y[0], y[1]); w.y = cvt_pk_bf16(y[2], y[3]); *(u32x2*)(HB + (size_t)r * DM + c) = w; } }
    }
}
__device__ void finalize_phase(const Params& p, int l, const bf16_t* PROJ, const float* OSSD, const float* ODN, bf16_t* MIXB) {
    const int tid = otid(); const int lane = tid & 63, wave = tid >> 6;
    float nws[8], nwd[4];
#pragma unroll
    for (int e = 0; e < 8; ++e) nws[e] = p.in[20][l * 512 + lane * 8 + e];
#pragma unroll
    for (int e = 0; e < 4; ++e) nwd[e] = p.in[24][l * 64 + (lane & 15) * 4 + e];
    for (int r = blockIdx.x * 8 + wave; r < MROWS; r += gridDim.x * 8) {
        {
            const f32x4 y0 = *(const f32x4*)(OSSD + (size_t)r * 512 + lane * 8), y1 = *(const f32x4*)(OSSD + (size_t)r * 512 + lane * 8 + 4);
            const u32x4 zr = *(const u32x4*)(PROJ + (size_t)r * LDP + 512 + lane * 8);
            float v[8]; const float z[8] = {bf_lo(zr.x), bf_hi(zr.x), bf_lo(zr.y), bf_hi(zr.y), bf_lo(zr.z), bf_hi(zr.z), bf_lo(zr.w), bf_hi(zr.w)};
            float ss = 0.f;
#pragma unroll
            for (int e = 0; e < 8; ++e) { const float yy = e < 4 ? y0[e & 3] : y1[e & 3]; v[e] = yy * siluf_(z[e]); ss += v[e] * v[e]; }
            ss = allreduce16(ss); { const float lo = rl_(ss, 0) + rl_(ss, 16), hi = rl_(ss, 32) + rl_(ss, 48); ss = (lane < 32) ? lo : hi; }
            const float rs = rsqrtf(ss * (1.f / 256.f) + 1e-6f);
#pragma unroll
            for (int e = 0; e < 8; ++e) v[e] = v[e] * rs * nws[e];
            u32x4 w; w.x = cvt_pk_bf16(v[0], v[1]); w.y = cvt_pk_bf16(v[2], v[3]); w.z = cvt_pk_bf16(v[4], v[5]); w.w = cvt_pk_bf16(v[6], v[7]);
            *(u32x4*)(MIXB + (size_t)r * DM + 256 + lane * 8) = w;
        }
        {
            const f32x4 o = *(const f32x4*)(ODN + (size_t)r * 256 + lane * 4);
            const u32x2 gr = *(const u32x2*)(PROJ + (size_t)r * LDP + 2560 + lane * 4);
            const float gt[4] = {bf_lo(gr.x), bf_hi(gr.x), bf_lo(gr.y), bf_hi(gr.y)};
            float ss = (o[0] * o[0] + o[1] * o[1]) + (o[2] * o[2] + o[3] * o[3]);
            ss = allreduce16(ss);
            const float rs = rsqrtf(ss * (1.f / 64.f) + 1e-6f);
            float v[4];
#pragma unroll
            for (int e = 0; e < 4; ++e) v[e] = o[e] * rs * nwd[e] * siluf_(gt[e]);
            u32x2 w; w.x = cvt_pk_bf16(v[0], v[1]); w.y = cvt_pk_bf16(v[2], v[3]);
            *(u32x2*)(MIXB + (size_t)r * DM + 768 + lane * 4) = w;
        }
    }
}

struct Raw8 { u32x4 r[4]; };
struct Raw4 { u32x2 r[4]; };
__device__ __forceinline__ void load_raw8(Raw8& R, const bf16_t* PROJ, int b, int t, int col, bool valid) {
#pragma unroll
    for (int j = 0; j < 4; ++j) { const int tt = t - 3 + j; u32x4 z = {0u, 0u, 0u, 0u}; if (valid && tt >= 0) z = *(const u32x4*)(PROJ + (size_t)rowi(b, tt) * LDP + col); R.r[j] = z; }
}
__device__ __forceinline__ void load_raw4(Raw4& R, const bf16_t* pb, int t, int col, bool valid) {
#pragma unroll
    for (int j = 0; j < 4; ++j) { const int tt = t - 3 + j; u32x2 z = {0u, 0u}; if (valid && tt >= 0) z = *(const u32x2*)(pb + (size_t)tt * LDP + col); R.r[j] = z; }
}
__device__ __forceinline__ void conv8(const Raw8& R, const float* __restrict__ cw, int C, int cc, const float* __restrict__ cb, float (&out)[8]) {
#pragma unroll
    for (int e = 0; e < 8; ++e) out[e] = cb ? cb[cc + e] : 0.f;
#pragma unroll
    for (int j = 0; j < 4; ++j) { const f32x4 w0 = *(const f32x4*)(cw + j * C + cc), w1 = *(const f32x4*)(cw + j * C + cc + 4); const u32x4 x = R.r[j];
        out[0] += w0[0] * bf_lo(x.x); out[1] += w0[1] * bf_hi(x.x); out[2] += w0[2] * bf_lo(x.y); out[3] += w0[3] * bf_hi(x.y);
        out[4] += w1[0] * bf_lo(x.z); out[5] += w1[1] * bf_hi(x.z); out[6] += w1[2] * bf_lo(x.w); out[7] += w1[3] * bf_hi(x.w); }
}
__device__ __forceinline__ void conv4(const Raw4& R, const float* __restrict__ cw, int C, int cc, const float* __restrict__ cb, float (&out)[4]) {
#pragma unroll
    for (int e = 0; e < 4; ++e) out[e] = cb ? cb[cc + e] : 0.f;
#pragma unroll
    for (int j = 0; j < 4; ++j) { const f32x4 w0 = *(const f32x4*)(cw + j * C + cc); const u32x2 x = R.r[j];
        out[0] += w0[0] * bf_lo(x.x); out[1] += w0[1] * bf_hi(x.x); out[2] += w0[2] * bf_lo(x.y); out[3] += w0[3] * bf_hi(x.y); }
}


__device__ __forceinline__ float frcp_(float x) { return __builtin_amdgcn_rcpf(x); }
__device__ __forceinline__ float fsig_(float x) { return frcp_(1.f + __expf(-x)); }
__device__ __forceinline__ float fsilu_(float x) { return x * frcp_(1.f + __expf(-x)); }
__device__ __forceinline__ float fgelu_(float x) { const float z = 0.7978845608028654f * (x + 0.044715f * x * x * x); const float t = 1.f - 2.f * frcp_(1.f + __expf(2.f * z)); return 0.5f * x * (1.f + t); }
__device__ __forceinline__ float expm1_small_(float x) { return x * (1.f + x * (0.5f + x * (0.16666667f + x * (0.041666668f + x * (0.008333334f + x * 0.0013888889f))))); }
__device__ __forceinline__ float allreduce4(float x) { x += dpp_f<0xB1>(x); x += dpp_f<0x4E>(x); return x; }

constexpr int SQ_BUF = 16384 * 2 + 8192 + 512;
template <bool DN>
__device__ void seq_task(const Params& p, LAS unsigned char* lds, int l, int b, int hh, int half, const bf16_t* PROJ, const float* SMALL, float* OUT) {
    const int tid = otid();
    const bool stepper = tid < 256;
    const int g = hh >> 2;
    const int chA = DN ? hh * 64 : 512 + g * 64, chB = DN ? 256 + hh * 64 : 640 + g * 64, chV = DN ? 512 + hh * 64 + half * 32 : hh * 64 + half * 32;
    const int pcol = DN ? 1792 : 1024;
    const float* cw = p.in[DN ? 21 : 15] + (size_t)l * 4 * 768;
    const float* cb = DN ? nullptr : p.in[16] + (size_t)l * 768;
    const int ldo = DN ? 256 : 512;
    LAS float* Op0 = (LAS float*)(lds + 2 * SQ_BUF);
    constexpr int NCH = (TT + 63) / 64;
    if (stepper) {
        const int j = tid >> 3, s = tid & 7;
        const float Dh = DN ? 0.f : p.in[19][l * 8 + hh];
        f32x2 S0 = {0.f, 0.f}, S1 = {0.f, 0.f}, S2 = {0.f, 0.f}, S3 = {0.f, 0.f};
        __syncthreads();
        for (int c = 0; c < NCH; ++c) {
            const int t0 = c * 64, len = (TT - t0) < 64 ? (TT - t0) : 64, cur = c & 1;
            const LAS f32x4* PA = (const LAS f32x4*)(lds + cur * SQ_BUF);
            const LAS f32x4* PB = (const LAS f32x4*)(lds + cur * SQ_BUF + 16384);
            const LAS float* PV = (const LAS float*)(lds + cur * SQ_BUF + 32768);
            const LAS f32x2* SC = (const LAS f32x2*)(lds + cur * SQ_BUF + 40960);
            LAS float* Op = Op0 + cur * 2048;
            const int nblk = len >> 3;
            for (int i = 0; i < nblk; ++i) {
                float oA = 0.f;
#pragma unroll
                for (int u = 0; u < 8; ++u) {
                    const int t = i * 8 + u;
                    const f32x4 a0 = PA[t * 16 + 2 * s], a1 = PA[t * 16 + 2 * s + 1], b0 = PB[t * 16 + 2 * s], b1 = PB[t * 16 + 2 * s + 1];
                    const f32x2 sc = SC[t]; const float vj = PV[t * 32 + j];
                    float o;
                    if (DN) {
                        S0 *= sc.x; S1 *= sc.x; S2 *= sc.x; S3 *= sc.x;
                        f32x2 r2 = b0.xy * S0; r2 += b0.zw * S1; r2 += b1.xy * S2; r2 += b1.zw * S3;
                        float r = r2.x + r2.y; r = allreduce8(r);
                        const float vn = sc.y * (vj - r);
                        S0 += b0.xy * vn; S1 += b0.zw * vn; S2 += b1.xy * vn; S3 += b1.zw * vn;
                        f32x2 o2 = a0.xy * S0; o2 += a0.zw * S1; o2 += a1.xy * S2; o2 += a1.zw * S3;
                        o = o2.x + o2.y; o = allreduce8(o);
                    } else {
                        const float xd = vj * sc.y;
                        S0 = S0 * sc.x + a0.xy * xd; S1 = S1 * sc.x + a0.zw * xd; S2 = S2 * sc.x + a1.xy * xd; S3 = S3 * sc.x + a1.zw * xd;
                        f32x2 y2 = b0.xy * S0; y2 += b0.zw * S1; y2 += b1.xy * S2; y2 += b1.zw * S3;
                        o = y2.x + y2.y; o = allreduce8(o);
                        o += Dh * vj;
                    }
                    oA = (s == u) ? o : oA;
                    if (u == 3) __builtin_amdgcn_sched_barrier(0);
                }
                Op[(i * 8 + s) * 32 + j] = oA;
            }
            __syncthreads();
        }
        __syncthreads();
    } else {
        const int st = tid - 256, tok = st >> 2, part = st & 3;
        const float nega = -expf(p.in[DN ? 22 : 18][l * (DN ? 4 : 8) + hh]), dtb = p.in[DN ? 23 : 17][l * (DN ? 4 : 8) + hh];
        const int cA = chA + part * 16, cB = chB + part * 16, cV = chV + part * 8;
        Raw8 ra0, ra1, rb0, rb1, rv;
        float scx = 1.f, scy = 0.f;
#define SQ_LOAD(tq, vld) do { load_raw8(ra0, PROJ, b, (tq), pcol + cA, (vld)); load_raw8(ra1, PROJ, b, (tq), pcol + cA + 8, (vld)); load_raw8(rb0, PROJ, b, (tq), pcol + cB, (vld)); \
        load_raw8(rb1, PROJ, b, (tq), pcol + cB + 8, (vld)); load_raw8(rv, PROJ, b, (tq), pcol + cV, (vld)); } while (0)
#define SQ_PANEL(r0, r1, cc, base_off, isq) do { float x0[8], x1[8]; conv8(r0, cwl, 768, (cc), cbl, x0); conv8(r1, cwl, 768, (cc) + 8, cbl, x1); \
        _Pragma("unroll") for (int e = 0; e < 8; ++e) { x0[e] = fsilu_(x0[e]); x1[e] = fsilu_(x1[e]); } \
        if (DN) { float sq = 0.f; _Pragma("unroll") for (int e = 0; e < 8; ++e) sq += x0[e] * x0[e] + x1[e] * x1[e]; \
            sq = allreduce4(sq); const float rs = rsqrtf(sq + 1e-6f) * ((isq) ? 0.125f : 1.f); \
            _Pragma("unroll") for (int e = 0; e < 8; ++e) { x0[e] *= rs; x1[e] *= rs; } } \
        LAS f32x4* Pw = (LAS f32x4*)(lds + (base_off)) + tok * 16 + part * 4; \
        Pw[0] = (f32x4){x0[0], x0[1], x0[2], x0[3]}; Pw[1] = (f32x4){x0[4], x0[5], x0[6], x0[7]}; Pw[2] = (f32x4){x1[0], x1[1], x1[2], x1[3]}; Pw[3] = (f32x4){x1[4], x1[5], x1[6], x1[7]}; } while (0)
#define SQ_STAGE(bufi, t0n) do { \
        const float* cwl = cw; const float* cbl = cb; asm volatile("" : "+v"(cwl), "+v"(cbl)); \
        SQ_PANEL(ra0, ra1, cA, (bufi) * SQ_BUF, true); \
        SQ_PANEL(rb0, rb1, cB, (bufi) * SQ_BUF + 16384, false); \
        { float v8[8]; conv8(rv, cwl, 768, cV, cbl, v8); \
          _Pragma("unroll") for (int e = 0; e < 8; ++e) v8[e] = fsilu_(v8[e]); \
          LAS f32x4* PVw = (LAS f32x4*)(lds + (bufi) * SQ_BUF + 32768) + tok * 8 + part * 2; \
          PVw[0] = (f32x4){v8[0], v8[1], v8[2], v8[3]}; PVw[1] = (f32x4){v8[4], v8[5], v8[6], v8[7]}; } \
        if (st < 64) { f32x2 sc = {1.f, 0.f}; \
            if ((t0n) + st < TT) { const float* sp = SMALL + (size_t)rowi(b, (t0n) + st) * 16; \
                if (DN) { const float gg = nega * softplusf_(sp[12 + hh] + dtb); sc.x = __expf(gg); sc.y = fsig_(sp[8 + hh]); } \
                else { const float dt = softplusf_(sp[hh] + dtb); sc.x = __expf(dt * nega); sc.y = dt; } } \
            ((LAS f32x2*)(lds + (bufi) * SQ_BUF + 40960))[st] = sc; } } while (0)
#define SQ_COPYOUT(bufi, t0o) do { if ((t0o) + tok < TT && ((t0o) + tok >= NMETA || b == 0)) { const LAS f32x4* src = (const LAS f32x4*)(Op0 + (bufi) * 2048) + tok * 8 + part * 2; \
        float* dst = OUT + (size_t)rowi(b, (t0o) + tok) * ldo + hh * 64 + half * 32 + part * 8; const f32x4 x0 = src[0], x1 = src[1]; *(f32x4*)dst = x0; *(f32x4*)(dst + 4) = x1; } } while (0)
        SQ_LOAD(tok, true);
        SQ_STAGE(0, 0);
        SQ_LOAD(64 + tok, true);
        __syncthreads();
        for (int c = 0; c < NCH; ++c) {
            const int cur = c & 1;
            if (c > 0) SQ_COPYOUT(cur ^ 1, (c - 1) * 64);
            if (c + 1 < NCH) { SQ_STAGE(cur ^ 1, (c + 1) * 64);
                if (c + 2 < NCH) { const int tn = (c + 2) * 64 + tok; const bool vld = tn < TT; SQ_LOAD(tn, vld); } }
            __syncthreads();
        }
        SQ_COPYOUT((NCH - 1) & 1, (NCH - 1) * 64);
        __syncthreads();
#undef SQ_LOAD
#undef SQ_STAGE
#undef SQ_PANEL
#undef SQ_COPYOUT
    }
}

__device__ void lru_task(const Params& p, LAS unsigned char* lds, int l, int b, int hd, int half, const bf16_t* PROJ, bf16_t* MIXB) {
    LAS float* Uf = (LAS float*)lds;
    LAS bf16_t* Ub = (LAS bf16_t*)(lds + 16384);
    LAS float* Yg = (LAS float*)(lds + 25600);
    LAS float* Ap = (LAS float*)(lds + 33792);
    LAS float* Mp = (LAS float*)(lds + 41984);
    LAS float* Ip = (LAS float*)(lds + 50176);
    LAS float* SegP = (LAS float*)(lds + 58368);
    LAS float* SegH = (LAS float*)(lds + 60416);
    LAS float* Hst = (LAS float*)(lds + 62464);
    LAS bf16_t* Ob = (LAS bf16_t*)(lds + 62592);
    const int tid = otid(), tok = tid >> 3, part = tid & 7, lane = tid & 63, wave = tid >> 6, fr = lane & 15, fq = lane >> 4;
    const float* cw = p.in[8] + (size_t)l * 4 * 256; const float* cb = p.in[9] + (size_t)l * 256;
    const int uc = hd * 64 + part * 8;
    const int yc = 256 + hd * 64 + half * 32 + part * 4;
    const int gt = wave >> 2, cbk = (wave >> 1) & 1, mh = wave & 1, ocl = cbk * 16 + fr, ocg = half * 32 + ocl;
    const float* W = p.in[gt ? 12 : 10] + (size_t)(l * 4 + hd) * 64 * 64;
    bf16x8 bfrag[2];
#pragma unroll
    for (int ks = 0; ks < 2; ++ks) { float w[8];
#pragma unroll
        for (int e = 0; e < 8; ++e) w[e] = W[(ks * 32 + 8 * fq + e) * 64 + ocg];
        u32x4 pk; pk.x = cvt_pk_bf16(w[0], w[1]); pk.y = cvt_pk_bf16(w[2], w[3]); pk.z = cvt_pk_bf16(w[4], w[5]); pk.w = cvt_pk_bf16(w[6], w[7]);
        bfrag[ks] = __builtin_bit_cast(bf16x8, pk); }
    const float gbias = p.in[gt ? 13 : 11][l * 256 + hd * 64 + ocg];
    const float c8 = -8.f * softplusf_(-p.in[14][l * 256 + hd * 64 + ocg]);
    if (tid < 32) Hst[tid] = 0.f;
    Raw8 ru; u32x2 ry;
    load_raw8(ru, PROJ, b, tok, uc, true); ry = *(const u32x2*)(PROJ + (size_t)rowi(b, tok) * LDP + yc);
    const int ch = tid & 31, seg = tid >> 5;
    for (int t0 = 0; t0 < TT; t0 += 64) {
        const int len = (TT - t0) < 64 ? (TT - t0) : 64;
        {   float u8[8]; conv8(ru, cw, 256, uc, cb, u8);
            if (tok >= len) {
#pragma unroll
                for (int e = 0; e < 8; ++e) u8[e] = 0.f; }
            f32x4 a0 = {u8[0], u8[1], u8[2], u8[3]}, a1 = {u8[4], u8[5], u8[6], u8[7]};
            *(LAS f32x4*)(Uf + tok * 64 + part * 8) = a0; *(LAS f32x4*)(Uf + tok * 64 + part * 8 + 4) = a1;
            u32x4 pk; pk.x = cvt_pk_bf16(u8[0], u8[1]); pk.y = cvt_pk_bf16(u8[2], u8[3]); pk.z = cvt_pk_bf16(u8[4], u8[5]); pk.w = cvt_pk_bf16(u8[6], u8[7]);
            *(LAS u32x4*)(Ub + tok * 72 + part * 8) = pk;
            f32x4 g0 = {fgelu_(bf_lo(ry.x)), fgelu_(bf_hi(ry.x)), fgelu_(bf_lo(ry.y)), fgelu_(bf_hi(ry.y))};
            *(LAS f32x4*)(Yg + tok * 32 + part * 4) = g0;
        }
        __syncthreads();
        if (t0 + 64 < TT) { const int tn = t0 + 64 + tok; const bool vld = tn < TT;
            load_raw8(ru, PROJ, b, tn, uc, vld); u32x2 z = {0u, 0u}; if (vld) z = *(const u32x2*)(PROJ + (size_t)rowi(b, tn) * LDP + yc); ry = z; }
#pragma unroll
        for (int mm = 0; mm < 2; ++mm) { const int m = 2 * mh + mm;
            f32x4 acc = {0.f, 0.f, 0.f, 0.f};
#pragma unroll
            for (int ks = 0; ks < 2; ++ks) { const bf16x8 a = *(const LAS bf16x8*)(Ub + (16 * m + fr) * 72 + ks * 32 + 8 * fq); acc = __builtin_amdgcn_mfma_f32_16x16x32_bf16(a, bfrag[ks], acc, 0, 0, 0); }
#pragma unroll
            for (int jj = 0; jj < 4; ++jj) { const int tk = 16 * m + 4 * fq + jj; const float v = fsig_(acc[jj] + gbias);
                if (gt == 0) { const float la = c8 * v, l2 = 2.f * la;
                    const float av = (la > -0.25f) ? 1.f + expm1_small_(la) : __expf(la);
                    const float om = (l2 > -0.25f) ? -expm1_small_(l2) : 1.f - __expf(l2);
                    Ap[tk * 32 + ocl] = av; Mp[tk * 32 + ocl] = __builtin_amdgcn_sqrtf(om); }
                else Ip[tk * 32 + ocl] = v; }
        }
        __syncthreads();
        float hl[4], plv[4];
        {   float hloc = 0.f, P = 1.f;
#pragma unroll
            for (int e = 0; e < 4; ++e) { const int t = seg * 4 + e; float a = Ap[t * 32 + ch], bb = Mp[t * 32 + ch] * Ip[t * 32 + ch] * Uf[t * 64 + half * 32 + ch];
                if (t >= len) { a = 1.f; bb = 0.f; }
                hloc = a * hloc + bb; P *= a; hl[e] = hloc; plv[e] = P; }
            SegP[seg * 32 + ch] = P; SegH[seg * 32 + ch] = hloc;
        }
        __syncthreads();
        float c = Hst[ch];
#pragma unroll
        for (int s2 = 0; s2 < 15; ++s2) if (s2 < seg) c = SegP[s2 * 32 + ch] * c + SegH[s2 * 32 + ch];
        float hlast = 0.f;
#pragma unroll
        for (int e = 0; e < 4; ++e) { const int t = seg * 4 + e; const float hh = hl[e] + plv[e] * c; hlast = hh; const float o = hh * Yg[t * 32 + ch];
            Ob[t * 32 + ch] = (bf16_t)(cvt_pk_bf16(o, 0.f) & 0xffffu); }
        __syncthreads();
        if (seg == 15) Hst[ch] = hlast;
        if (tok < len && (t0 + tok >= NMETA || b == 0)) *(u32x2*)(MIXB + (size_t)rowi(b, t0 + tok) * DM + hd * 64 + half * 32 + part * 4) = *(const LAS u32x2*)(Ob + tok * 32 + part * 4);
    }
    __syncthreads();
}

__device__ void mixer_phase(const Params& p, LAS unsigned char* lds, int l, const bf16_t* PROJ, const float* SMALL, float* OSSD, float* ODN, bf16_t* MIXB) {
    for (int task = blockIdx.x; task < 256; task += gridDim.x) {
        if (task < 64) { const int b = task >> 3, h = (task >> 1) & 3, c2 = task & 1; seq_task<true>(p, lds, l, b, h, c2, PROJ, SMALL, ODN); }
        else if (task < 192) { const int k = task - 64; const int b = k >> 4, hd = (k >> 1) & 7, ph = k & 1; seq_task<false>(p, lds, l, b, hd, ph, PROJ, SMALL, OSSD); }
        else { const int k = task - 192; lru_task(p, lds, l, k >> 3, (k >> 1) & 3, k & 1, PROJ, MIXB); }
    }
}

__device__ __forceinline__ const Params& kparams() { int z = 0; asm volatile("" : "+s"(z)); const char* kp = (const char*)__builtin_amdgcn_kernarg_segment_ptr(); return *(const Params*)(kp + z); }
__device__ __forceinline__ void gsync(unsigned& nbar) {
#ifdef USE_CG_SYNC
    cg::this_grid().sync(); return;
#endif
    const Params& p = kparams();
    unsigned* cnt = (unsigned*)(p.ws + WS_END);
    __threadfence();
    __syncthreads();
    ++nbar;
    if (otid() == 0) {
        __hip_atomic_fetch_add(cnt, 1u, __ATOMIC_RELEASE, __HIP_MEMORY_SCOPE_AGENT);
        const unsigned target = nbar * gridDim.x;
        while (__hip_atomic_load(cnt, __ATOMIC_RELAXED, __HIP_MEMORY_SCOPE_AGENT) < target) __builtin_amdgcn_s_sleep(1);
    }
    __syncthreads();
    __builtin_amdgcn_fence(__ATOMIC_ACQUIRE, "agent");
}
#define KP_VIEWS() const Params& p = kparams(); unsigned char* ws = p.ws; float* H = (float*)(ws + WS_H); bf16_t* HB = (bf16_t*)(ws + WS_HB); \
    bf16_t* ACT = (bf16_t*)(ws + WS_U); bf16_t* PROJ = (bf16_t*)(ws + WS_U); float* SMALL = (float*)(ws + WS_SMALL); float* OSSD = (float*)(ws + WS_HB); \
    bf16_t* MIXB = (bf16_t*)((unsigned char*)p.out + DO_MIXB); float* ODN = (float*)((unsigned char*)p.out + DO_ODN); \
    int G = gridDim.x, c = blockIdx.x; asm volatile("" : "+s"(G), "+s"(c)); (void)H; (void)HB; (void)ACT; (void)PROJ; (void)SMALL; (void)OSSD; (void)MIXB; (void)ODN; (void)G; (void)c;
__global__ void __launch_bounds__(NTHR, 2) hymba_mega(Params p_unused) {
    extern __shared__ __attribute__((aligned(16))) unsigned char lds_raw[];
    LAS unsigned char* lds = (LAS unsigned char*)lds_raw;
    cg::grid_group grid = cg::this_grid();
    {   KP_VIEWS();
        build_h(p, H, HB);
        convert_layer(p, lds, 0, ws + WS_WB); }
    grid.sync();
    unsigned nbar = 0;
#pragma unroll 1
    for (int l = 0; l < DEPTH; ++l) {
#pragma unroll 1
        for (int f = 0; f < 2; ++f) {
            if (f == 1) {
                {   KP_VIEWS(); unsigned char* wset = ws + WS_WB + (size_t)(l & 1) * SZ_WSET;
                    pg8::Gemm g{HB, (const bf16_t*)(wset + WO_IN), MMAIN, NINP, DM}; pg8::StaticOrder S; S.init(MMAIN, NINP, G, c);
                    EpiProj E{PROJ, SMALL}; pg8::gemm_phase<EpiProj, pg8::StaticOrder>(lds, g, S, E, nullptr);
                    TailProj TE{PROJ, SMALL}; skinny_gemm(lds, HB, DM, (const bf16_t*)(wset + WO_IN), DM, 89, TE); }
                gsync(nbar);
                {   KP_VIEWS(); mixer_phase(p, lds, l, PROJ, SMALL, OSSD, ODN, MIXB); }
                gsync(nbar);
                {   KP_VIEWS(); finalize_phase(p, l, PROJ, OSSD, ODN, MIXB); }
                gsync(nbar);
                {   KP_VIEWS(); unsigned char* wset = ws + WS_WB + (size_t)(l & 1) * SZ_WSET;
                    pg8::Gemm g{MIXB, (const bf16_t*)(wset + WO_OUT), MMAIN, DM, DM}; pg8::StaticOrder S; S.init(MMAIN, DM, G, c);
                    EpiResid E{H, 1.0f}; pg8::gemm_phase<EpiResid, pg8::StaticOrder>(lds, g, S, E, nullptr);
                    TailResid TE{H, 1.0f}; skinny_gemm(lds, MIXB, DM, (const bf16_t*)(wset + WO_OUT), DM, 32, TE); }
                gsync(nbar);
                {   KP_VIEWS(); ln_phase(H, HB, p.in[2] + (size_t)(l * 3 + 1) * DM, p.in[3] + (size_t)(l * 3 + 1) * DM, nullptr); }
                gsync(nbar);
            }
            {   KP_VIEWS(); unsigned char* wset = ws + WS_WB + (size_t)(l & 1) * SZ_WSET;
                pg8::Gemm g{HB, (const bf16_t*)(wset + (f ? WO_GU1 : WO_GU0)), MMAIN, 2 * DFF, DM}; pg8::StaticOrder S; S.init(MMAIN, 2 * DFF, G, c);
                EpiSwiGLU E{ACT}; pg8::gemm_phase<EpiSwiGLU, pg8::StaticOrder>(lds, g, S, E, nullptr);
                TailSwiGLU TE{ACT}; skinny_gemm(lds, HB, DM, (const bf16_t*)(wset + (f ? WO_GU1 : WO_GU0)), DM, 176, TE); }
            gsync(nbar);
            {   KP_VIEWS(); unsigned char* wset = ws + WS_WB + (size_t)(l & 1) * SZ_WSET;
                pg8::Gemm g{ACT, (const bf16_t*)(wset + (f ? WO_D1 : WO_D0)), MMAIN, DM, DFF}; pg8::StaticOrder S; S.init(MMAIN, DM, G, c);
                EpiResid E{H, 0.5f}; pg8::gemm_phase<EpiResid, pg8::StaticOrder>(lds, g, S, E, nullptr);
                TailResid TE{H, 0.5f}; skinny_gemm(lds, ACT, DFF, (const bf16_t*)(wset + (f ? WO_D1 : WO_D0)), DFF, 32, TE); }
            gsync(nbar);
            {   KP_VIEWS(); const int li = l * 3 + (f ? 2 : 0);
                ln_phase(H, HB, p.in[2] + (size_t)li * DM, p.in[3] + (size_t)li * DM, (l == DEPTH - 1 && f == 1) ? p.out : nullptr);
                if (f == 0 && l + 1 < DEPTH) convert_layer(p, lds, l + 1, ws + WS_WB + (size_t)((l + 1) & 1) * SZ_WSET); }
            gsync(nbar);
        }
    }
}

extern "C" void kernel_launch(void* const* d_in, const int* in_sizes, int n_in, void* d_out, int out_size, void* d_ws, size_t ws_size, hipStream_t stream) {
    static int grid_blocks = 0;
    if (!grid_blocks) {
        int dev = 0, cus = 0, per_cu = 0;
        hipGetDevice(&dev);
        hipDeviceGetAttribute(&cus, hipDeviceAttributeMultiprocessorCount, dev);
        hipFuncSetAttribute((const void*)hymba_mega, hipFuncAttributeMaxDynamicSharedMemorySize, LDS_BYTES);
        hipOccupancyMaxActiveBlocksPerMultiprocessor(&per_cu, (const void*)hymba_mega, NTHR, LDS_BYTES);
        if (per_cu < 1) per_cu = 1;
        grid_blocks = cus * per_cu;
        if (ws_size < WS_END + 256) fprintf(stderr, "workspace too small: %zu < %zu\n", ws_size, (size_t)WS_END);
    }
    (void)hipMemsetAsync((unsigned char*)d_ws + WS_END, 0, 256, stream);
    Params p{};
    for (int i = 0; i < 26; ++i) p.in[i] = (const float*)d_in[i];
    p.out = (float*)d_out; p.ws = (unsigned char*)d_ws;
    void* args[] = {&p};
    hipError_t e = hipLaunchCooperativeKernel((const void*)hymba_mega, dim3(grid_blocks), dim3(NTHR), args, LDS_BYTES, stream);
    if (e != hipSuccess) fprintf(stderr, "cooperative launch failed: %s (grid %d)\n", hipGetErrorString(e), grid_blocks);
}
```
